# Optimizing an MI355X kernel written in HIP

```python
import jax, jax.numpy as jnp
from jax import lax
import numpy as np

D_MODEL = 1024
BATCH = 8
SEQ = 2048
DEPTH = 1

HGRN_HEADS = 8
HGRN_EXPAND = 128
HGRN_FWD = HGRN_HEADS * HGRN_EXPAND
HGRN_IN = D_MODEL
HGRN_VDIM = HGRN_IN // HGRN_HEADS
HGRN_SCALE = HGRN_EXPAND ** -0.5
CHUNK = 32
RWKV_HEAD = 64
RWKV_DIM = D_MODEL
RWKV_HEADS = RWKV_DIM // RWKV_HEAD
W_LORA = 64
A_LORA = 64
G_LORA = 128
GN_EPS = 1e-5 * RWKV_HEAD
D_FF = 2816
CONV_W = 3
EPS = 1e-6

HGRN_COLS = 2 * HGRN_FWD + 2 * HGRN_IN
RWKV_COLS = 3 * RWKV_DIM + W_LORA + A_LORA + G_LORA
GATE_COLS = 2 * D_MODEL
IN_COLS = HGRN_COLS + RWKV_COLS + GATE_COLS

kernel_name = "hgrn2_rwkv7_gated_hybrid_convffn"

F32 = jnp.float32


def _rmsnorm(x, g):
    xf = x.astype(F32)
    y = xf * lax.rsqrt(jnp.mean(xf * xf, axis=-1, keepdims=True) + EPS)
    return (y * g.astype(F32)).astype(x.dtype)


def _split(z, sizes):
    outs, off = [], 0
    for s in sizes:
        outs.append(z[..., off:off + s])
        off += s
    return outs


def _shift1(z):
    return jnp.pad(z[:, :-1], ((0, 0), (1, 0), (0, 0)))


def _causal_dwconv(h, w, b):
    S = h.shape[1]
    hp = jnp.pad(h, ((0, 0), (CONV_W - 1, 0), (0, 0)))
    out = b
    for j in range(CONV_W):
        out = out + w[j] * hp[:, j:j + S]
    return out


def _hgrn2_chunkwise(q, f_log, k, v):
    B, S, H, K = q.shape
    V = v.shape[-1]
    N = S // CHUNK

    def chunk(t):
        return t.reshape(B, N, CHUNK, H, t.shape[-1]).transpose(0, 3, 1, 2, 4)

    qc, gc, kc, vc = chunk(q), chunk(f_log), chunk(k), chunk(v)
    b = jnp.cumsum(gc, axis=3)
    b_ref = b[:, :, :, CHUNK // 2 - 1:CHUNK // 2, :]
    q_in = qc * jnp.exp(b - b_ref)
    k_in = kc * jnp.exp(b_ref - b)
    scores = jnp.einsum('bhnck,bhndk->bhncd', q_in, k_in)
    mask = jnp.tril(jnp.ones((CHUNK, CHUNK), dtype=bool))
    scores = jnp.where(mask, scores, 0.0)
    o_intra = jnp.einsum('bhncd,bhndv->bhncv', scores, vc)

    b_last = b[:, :, :, -1, :]
    u = jnp.einsum('bhnck,bhncv->bhnkv', kc * jnp.exp(b_last[:, :, :, None, :] - b), vc)
    decay = jnp.exp(b_last)

    def step(state, inp):
        d, u_n = inp
        return d[..., None] * state + u_n, state

    s0 = jnp.zeros((B, H, K, V), F32)
    _, s_prev = lax.scan(step, s0, (decay.transpose(2, 0, 1, 3), u.transpose(2, 0, 1, 3, 4)))
    s_prev = s_prev.transpose(1, 2, 0, 3, 4)
    o_inter = jnp.einsum('bhnck,bhnkv->bhncv', qc * jnp.exp(b), s_prev)
    o = o_intra + o_inter
    return o.transpose(0, 2, 3, 1, 4).reshape(B, S, H, V)


def _rwkv7_scan(r, w, k, v, a_vec, b_vec):
    B, S, H, N = r.shape

    def step(state, inp):
        r_t, w_t, k_t, v_t, a_t, b_t = inp
        sa = jnp.einsum('bhvk,bhk->bhv', state, a_t)
        state = (state * w_t[:, :, None, :] + sa[..., None] * b_t[:, :, None, :]
                 + v_t[..., None] * k_t[:, :, None, :])
        y = jnp.einsum('bhvk,bhk->bhv', state, r_t)
        return state, y

    xs = tuple(t.astype(F32).transpose(1, 0, 2, 3) for t in (r, w, k, v, a_vec, b_vec))
    _, y = lax.scan(step, jnp.zeros((B, H, N, N), F32), xs)
    return y.transpose(1, 0, 2, 3)


def _token_mixer(xn, lb, w_in, hgrn_gnorm, w_branch_a, rwkv_mu, rwkv_w0, rwkv_w2, rwkv_a0,
                 rwkv_a2, rwkv_g2, rwkv_k_k, rwkv_k_a, rwkv_r_k, rwkv_ln_w, rwkv_ln_b,
                 w_branch_b, w_out):
    B, S, _ = xn.shape
    z = xn @ w_in
    z_h, z_r, z_g = _split(z, [HGRN_COLS, RWKV_COLS, GATE_COLS])

    hq, hf, hi, hg = _split(z_h, [HGRN_FWD, HGRN_FWD, HGRN_IN, HGRN_IN])
    q = jax.nn.silu(hq.astype(F32)).reshape(B, S, HGRN_HEADS, HGRN_EXPAND) * HGRN_SCALE
    f = lb + (1.0 - lb) * jax.nn.sigmoid(hf.astype(F32))
    f = f.reshape(B, S, HGRN_HEADS, HGRN_EXPAND)
    k_h = 1.0 - f
    vi = hi.astype(F32).reshape(B, S, HGRN_HEADS, HGRN_VDIM)
    o_a = _hgrn2_chunkwise(q, jnp.log(f), k_h, vi)
    o_a = o_a * lax.rsqrt(jnp.mean(o_a * o_a, axis=-1, keepdims=True) + EPS)
    o_a = o_a * hgrn_gnorm.astype(F32).reshape(HGRN_HEADS, HGRN_VDIM)
    o_a = o_a.reshape(B, S, HGRN_IN) * jax.nn.silu(hg.astype(F32))
    y_a = o_a.astype(xn.dtype) @ w_branch_a

    z_r = z_r + rwkv_mu * (_shift1(z_r) - z_r)
    rr, kr, vr, wz, az, gz = _split(z_r, [RWKV_DIM, RWKV_DIM, RWKV_DIM, W_LORA, A_LORA, G_LORA])
    w_log = -jax.nn.softplus(-(rwkv_w0 + jnp.tanh(wz) @ rwkv_w2).astype(F32)) - 0.5
    decay = jnp.exp(-jnp.exp(w_log))
    a = jax.nn.sigmoid((rwkv_a0 + az @ rwkv_a2).astype(F32))
    g = jax.nn.sigmoid(gz) @ rwkv_g2
    kr = kr.astype(F32)
    kk = (kr * rwkv_k_k).reshape(B, S, RWKV_HEADS, RWKV_HEAD)
    kk = kk / jnp.maximum(jnp.linalg.norm(kk, axis=-1, keepdims=True), 1e-12)
    kr = kr * (1.0 + (a - 1.0) * rwkv_k_a)

    def heads(t):
        return t.astype(F32).reshape(B, S, RWKV_HEADS, RWKV_HEAD)

    r_h, k_r, v_r, w_h, a_h = heads(rr), heads(kr), heads(vr), heads(decay), heads(a)
    y = _rwkv7_scan(r_h, w_h, k_r, v_r, -kk, kk * a_h)
    mu_y = jnp.mean(y, axis=-1, keepdims=True)
    var_y = jnp.mean(jnp.square(y - mu_y), axis=-1, keepdims=True)
    y = ((y - mu_y) * lax.rsqrt(var_y + GN_EPS)).reshape(B, S, RWKV_DIM)
    y = y * rwkv_ln_w.astype(F32) + rwkv_ln_b.astype(F32)
    bonus = jnp.sum(r_h * k_r * rwkv_r_k.astype(F32), axis=-1, keepdims=True) * v_r
    o_b = (y + bonus.reshape(B, S, RWKV_DIM)) * g.astype(F32)
    y_b = o_b.astype(xn.dtype) @ w_branch_b

    ga, gb = _split(z_g, [D_MODEL, D_MODEL])
    merged = jax.nn.sigmoid(ga) * y_a + jax.nn.sigmoid(gb) * y_b
    return merged @ w_out


def _conv_ffn(xn, w_up, conv_w, conv_b, w_down):
    hu = xn @ w_up
    hc = _causal_dwconv(hu, conv_w, conv_b)
    gate, val = _split(hc, [D_FF, D_FF])
    return (jax.nn.silu(gate) * val) @ w_down


def setup_inputs(seed: int = 0) -> dict:
    key = jax.random.key(seed)
    ks = jax.random.split(key, 32)
    L = DEPTH

    def nrm(k, shape, scale):
        return jax.random.normal(k, shape, F32) * scale

    def gain(k, shape):
        return 1.0 + 0.02 * jax.random.normal(k, shape, F32)

    return {
        "x": jax.random.normal(ks[0], (BATCH, SEQ, D_MODEL), F32),
        "attn_pre_norm": gain(ks[1], (L, D_MODEL)),
        "w_in": nrm(ks[2], (L, D_MODEL, IN_COLS), D_MODEL ** -0.5),
        "hgrn_lb": nrm(ks[3], (DEPTH + 1, HGRN_FWD), 0.1),
        "hgrn_gnorm": gain(ks[4], (L, HGRN_IN)),
        "w_branch_a": nrm(ks[5], (L, HGRN_IN, D_MODEL), HGRN_IN ** -0.5),
        "rwkv_mu": jax.random.uniform(ks[6], (L, RWKV_COLS), F32),
        "rwkv_w0": jax.random.uniform(ks[7], (L, RWKV_DIM), F32, minval=-6.0, maxval=0.0),
        "rwkv_w2": nrm(ks[8], (L, W_LORA, RWKV_DIM), 0.1 * W_LORA ** -0.5),
        "rwkv_a0": nrm(ks[9], (L, RWKV_DIM), 0.1),
        "rwkv_a2": nrm(ks[10], (L, A_LORA, RWKV_DIM), 0.5 * A_LORA ** -0.5),
        "rwkv_g2": nrm(ks[11], (L, G_LORA, RWKV_DIM), G_LORA ** -0.5),
        "rwkv_k_k": 0.85 + 0.02 * jax.random.normal(ks[12], (L, RWKV_DIM), F32),
        "rwkv_k_a": gain(ks[13], (L, RWKV_DIM)),
        "rwkv_r_k": nrm(ks[14], (L, RWKV_HEADS, RWKV_HEAD), 0.1),
        "rwkv_ln_w": gain(ks[15], (L, RWKV_DIM)),
        "rwkv_ln_b": nrm(ks[16], (L, RWKV_DIM), 0.01),
        "w_branch_b": nrm(ks[17], (L, RWKV_DIM, D_MODEL), RWKV_DIM ** -0.5),
        "w_out": nrm(ks[18], (L, D_MODEL, D_MODEL), D_MODEL ** -0.5),
        "attn_post_norm": gain(ks[19], (L, D_MODEL)),
        "ffn_pre_norm": gain(ks[20], (L, D_MODEL)),
        "w_up": nrm(ks[21], (L, D_MODEL, 2 * D_FF), D_MODEL ** -0.5),
        "conv_w": nrm(ks[22], (L, CONV_W, 2 * D_FF), CONV_W ** -0.5),
        "conv_b": nrm(ks[23], (L, 2 * D_FF), 0.01),
        "w_down": nrm(ks[24], (L, D_FF, D_MODEL), D_FF ** -0.5),
        "ffn_post_norm": gain(ks[25], (L, D_MODEL)),
    }


def reference(x, attn_pre_norm, w_in, hgrn_lb, hgrn_gnorm, w_branch_a, rwkv_mu, rwkv_w0,
              rwkv_w2, rwkv_a0, rwkv_a2, rwkv_g2, rwkv_k_k, rwkv_k_a, rwkv_r_k, rwkv_ln_w,
              rwkv_ln_b, w_branch_b, w_out, attn_post_norm, ffn_pre_norm, w_up, conv_w,
              conv_b, w_down, ffn_post_norm):
    lb_table = jnp.cumsum(jax.nn.softmax(hgrn_lb.astype(F32), axis=0), axis=0)
    h = x
    for l in range(DEPTH):
        xn = _rmsnorm(h, attn_pre_norm[l])
        mix = _token_mixer(xn, lb_table[l], w_in[l], hgrn_gnorm[l], w_branch_a[l], rwkv_mu[l],
                           rwkv_w0[l], rwkv_w2[l], rwkv_a0[l], rwkv_a2[l], rwkv_g2[l],
                           rwkv_k_k[l], rwkv_k_a[l], rwkv_r_k[l], rwkv_ln_w[l], rwkv_ln_b[l],
                           w_branch_b[l], w_out[l])
        h = h + _rmsnorm(mix, attn_post_norm[l])
        xn = _rmsnorm(h, ffn_pre_norm[l])
        ff = _conv_ffn(xn, w_up[l], conv_w[l], conv_b[l], w_down[l])
        h = h + _rmsnorm(ff, ffn_post_norm[l])
    return h
```

```cpp
#include <hip/hip_runtime.h>
#include <hip/hip_cooperative_groups.h>
#include <cstdio>
#include <cstdint>
namespace cg = cooperative_groups;

namespace pg8 {
#define PG8_LAS __attribute__((address_space(3)))
typedef unsigned short bf16_t;
typedef short bf16x8 __attribute__((ext_vector_type(8)));
typedef float f32x4 __attribute__((ext_vector_type(4)));
typedef float f32x2 __attribute__((ext_vector_type(2)));
typedef unsigned u32x4 __attribute__((ext_vector_type(4)));
typedef _Float16 h16x2 __attribute__((ext_vector_type(2)));
constexpr int BM = 256, BK = 64, HALF = 128, HTB = HALF * BK * 2  , STAGE_BYTES = 8 * HTB, NXCD = 8, WGM = 8;

__host__ __device__ __forceinline__ int lds_byte(int r, int c) { const int st = (r >> 4) * 2 + (c >> 5), rr = r & 15, cc = c & 31, ob = rr * 64 + cc * 2; return st * 1024 + (ob ^ (((ob >> 9) & 1) << 5)); }
__host__ __device__ __forceinline__ void stage_rc(int b, int& R, int& C) { const int st = b / 1024, sb = b % 1024, swz = sb ^ (((sb >> 9) & 1) << 5); R = (st >> 1) * 16 + swz / 64; C = (st & 1) * 32 + (swz % 64) / 2; }
__host__ __device__ __forceinline__ int perm32(int rho) { const int n = rho >> 4, i = rho & 15; return 8 * (i >> 2) + 4 * n + (i & 3); }

struct Unit { int pm, pn; };
struct Gemm { const bf16_t* A; const bf16_t* Bt; int M, N, K; };

struct StaticOrder {
    int nM, nN, nwg, G, c;
    __host__ __device__ void init(int M, int N, int G_, int c_) { nM = M / BM; nN = N / BM; nwg = nM * nN; G = G_; c = c_; }
    __host__ __device__ __forceinline__ bool next(int i, Unit& u) const {
        const long L = (long)i * G + c; if (L >= nwg) return false;
        int wgid = (int)L; { const int q = nwg / NXCD, r = nwg % NXCD, xcd = wgid % NXCD, off = wgid / NXCD; wgid = (xcd < r ? xcd * (q + 1) : r * (q + 1) + (xcd - r) * q) + off; }
        const int nig = WGM * nN, gid = wgid / nig, fm = gid * WGM, gsz = (nM - fm) < WGM ? (nM - fm) : WGM;
        u.pm = fm + ((wgid % nig) % gsz); u.pn = (wgid % nig) / gsz; return true;
    }
    __device__ __forceinline__ const char* pa(const Gemm& g, const Unit& u) const { return (const char*)g.A + (size_t)u.pm * ((size_t)BM * g.K * 2); }
    __device__ __forceinline__ const char* pb(const Gemm& g, const Unit& u) const { return (const char*)g.Bt + (size_t)u.pn * ((size_t)BM * g.K * 2); }
    __device__ __forceinline__ void a_ready(const Unit&) const {}
    __device__ __forceinline__ void done(const Unit&) const {}
};
struct OrderG3 {
    int pm, pn0, valid; const bf16_t *a_xn, *a_oa, *a_ob;
    __device__ __forceinline__ void init(int M, int N, int G_, int c_) { StaticOrder b; b.init(M, N, G_, c_); Unit t; t.pm = 0; t.pn = 0; valid = b.next(0, t) ? 1 : 0; pm = t.pm; pn0 = t.pn; }
    __device__ __forceinline__ bool next(int i, Unit& u) const { if (i >= 4 || !valid) return false; u.pm = pm; u.pn = 4 * i + pn0; return true; }
    __device__ __forceinline__ const char* pa(const Gemm& g, const Unit& u) const { const int s = u.pn >> 2; const long long d1 = (const char*)a_oa - (const char*)a_xn, d3 = (const char*)a_ob - (const char*)a_xn; const long long off = (long long)(s == 1) * d1 + (long long)(s == 3) * d3; return (const char*)a_xn + off + (size_t)u.pm * ((size_t)BM * g.K * 2); }
    __device__ __forceinline__ const char* pb(const Gemm& g, const Unit& u) const { return (const char*)g.Bt + (size_t)u.pn * ((size_t)BM * g.K * 2); }
    __device__ __forceinline__ void a_ready(const Unit&) const {}
    __device__ __forceinline__ void done(const Unit&) const {}
};

__device__ __forceinline__ unsigned cvt_pk_bf16(float lo, float hi) { unsigned r; asm volatile("v_cvt_pk_bf16_f32 %0, %1, %2" : "=v"(r) : "v"(lo), "v"(hi)); return r; }
__device__ __forceinline__ unsigned cvt_pk_f16(float lo, float hi) { h16x2 v; v.x = (_Float16)lo; v.y = (_Float16)hi; return __builtin_bit_cast(unsigned, v); }
__device__ __forceinline__ float fsigmoid(float x) { return __builtin_amdgcn_rcpf(1.0f + __expf(-x)); }

struct EpiG1 {
    static constexpr bool PERM = true, AFTER_DRAIN = false;
    bf16_t *Q, *KF, *VI, *HG, *R, *K, *V, *LZ; const float* lbraw;
    template <int MODE> __device__ __forceinline__ void tile(const f32x4 (&acc)[2][2][4][2], bf16_t* base, int ldc, int row0, int col0) const {
        float oml[2][8];
        if (MODE == 1) {
#pragma unroll
            for (int bj = 0; bj < 2; ++bj)
#pragma unroll
                for (int e = 0; e < 8; ++e) { const int c = col0 + bj * HALF + e; oml[bj][e] = fsigmoid(lbraw[1024 + c] - lbraw[c]); }
        }
#pragma unroll
        for (int ai = 0; ai < 2; ++ai)
#pragma unroll
            for (int m = 0; m < 4; ++m) { bf16_t* rowp = base + (size_t)(row0 + ai * HALF + m * 16) * ldc + col0;
#pragma unroll
                for (int bj = 0; bj < 2; ++bj) { float v[8];
#pragma unroll
                    for (int e = 0; e < 4; ++e) { v[e] = acc[ai][bj][m][0][e]; v[4 + e] = acc[ai][bj][m][1][e]; }
                    u32x4 w;
                    if (MODE == 0) {
#pragma unroll
                        for (int e = 0; e < 8; ++e) v[e] = v[e] * fsigmoid(v[e]) * 0.08838834764831845f;
                    } else if (MODE == 1) {
#pragma unroll
                        for (int e = 0; e < 8; ++e) v[e] = oml[bj][e] * fsigmoid(-v[e]);
                    } else if (MODE == 3) {
#pragma unroll
                        for (int e = 0; e < 8; ++e) v[e] = v[e] * fsigmoid(v[e]);
                    }
                    if (MODE == 1) { w.x = cvt_pk_f16(v[0], v[1]); w.y = cvt_pk_f16(v[2], v[3]); w.z = cvt_pk_f16(v[4], v[5]); w.w = cvt_pk_f16(v[6], v[7]); }
                    else { w.x = cvt_pk_bf16(v[0], v[1]); w.y = cvt_pk_bf16(v[2], v[3]); w.z = cvt_pk_bf16(v[4], v[5]); w.w = cvt_pk_bf16(v[6], v[7]); }
                    *(u32x4*)(rowp + bj * HALF) = w; } }
    }
    __device__ __forceinline__ void operator()(const f32x4 (&acc)[2][2][4][2], const Unit& u, int wr, int wc, int fr, int fq) const {
        const int pn = u.pn, row0 = u.pm * BM + wr * 64 + fr, cw = wc * 32 + 8 * fq;
        if (pn < 4) tile<0>(acc, Q, 1024, row0, pn * 256 + cw);
        else if (pn < 8) tile<1>(acc, KF, 1024, row0, (pn - 4) * 256 + cw);
        else if (pn < 12) tile<2>(acc, VI, 1024, row0, (pn - 8) * 256 + cw);
        else if (pn < 16) tile<3>(acc, HG, 1024, row0, (pn - 12) * 256 + cw);
        else if (pn < 20) tile<2>(acc, R, 1024, row0, (pn - 16) * 256 + cw);
        else if (pn < 24) tile<2>(acc, K, 1024, row0, (pn - 20) * 256 + cw);
        else if (pn < 28) tile<2>(acc, V, 1024, row0, (pn - 24) * 256 + cw);
        else tile<2>(acc, LZ, 256, row0, cw);
    }
};

struct EpiG3 {
    static constexpr bool PERM = true, AFTER_DRAIN = false;
    f32x4* scr;
    bf16_t* O;
    __device__ __forceinline__ void operator()(const f32x4 (&acc)[2][2][4][2], const Unit& u, int wr, int wc, int fr, int fq) const {
        const int s = u.pn >> 2, pn0 = u.pn & 3, tid = threadIdx.x;
        f32x4* t0 = scr + tid * 32; f32x4* t1 = scr + 32 * 512 + tid * 32;
        if (s == 0 || s == 2) { f32x4* t = s ? t1 : t0;
#pragma unroll
            for (int ai = 0; ai < 2; ++ai)
#pragma unroll
                for (int bj = 0; bj < 2; ++bj)
#pragma unroll
                    for (int m = 0; m < 4; ++m)
#pragma unroll
                        for (int n = 0; n < 2; ++n) { const f32x4 a = acc[ai][bj][m][n]; f32x4 r; r.x = fsigmoid(a.x); r.y = fsigmoid(a.y); r.z = fsigmoid(a.z); r.w = fsigmoid(a.w); t[((ai * 2 + bj) * 4 + m) * 2 + n] = r; }
        } else if (s == 1) {
#pragma unroll
            for (int ai = 0; ai < 2; ++ai)
#pragma unroll
                for (int bj = 0; bj < 2; ++bj)
#pragma unroll
                    for (int m = 0; m < 4; ++m)
                        { _Pragma("unroll") for (int n = 0; n < 2; ++n) { const int ix = ((ai * 2 + bj) * 4 + m) * 2 + n; t0[ix] = t0[ix] * acc[ai][bj][m][n]; } if (m & 1) asm volatile("" ::: "memory"); }
        } else {
            const int row0 = u.pm * BM + wr * 64 + fr, col0 = pn0 * BM + wc * 32 + 8 * fq;
#pragma unroll
            for (int ai = 0; ai < 2; ++ai)
#pragma unroll
                for (int m = 0; m < 4; ++m) { bf16_t* rowp = O + (size_t)(row0 + ai * HALF + m * 16) * 1024 + col0;
#pragma unroll
                    for (int bj = 0; bj < 2; ++bj) { const int ix = ((ai * 2 + bj) * 4 + m) * 2;
                        const f32x4 v0 = t0[ix] + t1[ix] * acc[ai][bj][m][0], v1 = t0[ix + 1] + t1[ix + 1] * acc[ai][bj][m][1];
                        u32x4 w; w.x = cvt_pk_bf16(v0[0], v0[1]); w.y = cvt_pk_bf16(v0[2], v0[3]); w.z = cvt_pk_bf16(v1[0], v1[1]); w.w = cvt_pk_bf16(v1[2], v1[3]);
                        *(u32x4*)(rowp + bj * HALF) = w; } asm volatile("" ::: "memory"); }
        }
    }
};

struct EpiF32SS {
    static constexpr bool PERM = false, AFTER_DRAIN = false;
    float* out; float* ssp; int ldc;
    __device__ __forceinline__ void operator()(const f32x4 (&acc)[2][2][4][2], const Unit& u, int wr, int wc, int fr, int fq) const {
        const int row0 = u.pm * BM + wr * 64 + fr, col0 = u.pn * BM + wc * 32 + 4 * fq;
#pragma unroll
        for (int ai = 0; ai < 2; ++ai)
#pragma unroll
            for (int m = 0; m < 4; ++m) { const int r = row0 + ai * HALF + m * 16; float s = 0.f;
#pragma unroll
                for (int bj = 0; bj < 2; ++bj)
#pragma unroll
                    for (int n = 0; n < 2; ++n) { const f32x4 x = acc[ai][bj][m][n]; s += (x[0] * x[0] + x[1] * x[1]) + (x[2] * x[2] + x[3] * x[3]); *(f32x4*)(out + (size_t)r * ldc + col0 + bj * HALF + n * 16) = x; }
                s += __shfl_xor(s, 16); s += __shfl_xor(s, 32);
                if (fq == 0) ssp[(size_t)r * 16 + u.pn * 4 + wc] = s; }
    }
};

struct EpiBf16Raw {
    static constexpr bool PERM = true, AFTER_DRAIN = false;
    bf16_t* O; int ldc;
    __device__ __forceinline__ void operator()(const f32x4 (&acc)[2][2][4][2], const Unit& u, int wr, int wc, int fr, int fq) const {
        const int row0 = u.pm * BM + wr * 64 + fr, col0 = u.pn * BM + wc * 32 + 8 * fq;
#pragma unroll
        for (int ai = 0; ai < 2; ++ai)
#pragma unroll
            for (int m = 0; m < 4; ++m) { bf16_t* rowp = O + (size_t)(row0 + ai * HALF + m * 16) * ldc + col0;
#pragma unroll
                for (int bj = 0; bj < 2; ++bj) { const f32x4 v0 = acc[ai][bj][m][0], v1 = acc[ai][bj][m][1];
                    u32x4 w; w.x = cvt_pk_bf16(v0[0], v0[1]); w.y = cvt_pk_bf16(v0[2], v0[3]); w.z = cvt_pk_bf16(v1[0], v1[1]); w.w = cvt_pk_bf16(v1[2], v1[3]);
                    *(u32x4*)(rowp + bj * HALF) = w; } }
    }
};

template <class Epi, class Sched, bool ALIGN_EPI = false, bool SP2 = false>
__device__ __forceinline__ void gemm_phase(PG8_LAS unsigned char* lds, const Gemm g, const Sched& S, const Epi& E) {
    const int tid = threadIdx.x, wid = __builtin_amdgcn_readfirstlane(tid >> 6), lane = tid & 63, wr = wid >> 2, wc = wid & 3, fr = lane & 15, fq = lane >> 4;
    const int K = g.K, nt = K / BK;
    unsigned voffA[2], voffB[2];
#pragma unroll
    for (int i = 0; i < 2; ++i) { int R, C; stage_rc(tid * 16 + i * 8192, R, C); const int Rb = Epi::PERM ? ((R & ~31) + perm32(R & 31)) : R;
        voffA[i] = (unsigned)(R * K + C) * 2u; voffB[i] = (unsigned)(Rb * K + C) * 2u; }
    const size_t kstep = (size_t)(BK * 2);
    const size_t hstep = (size_t)HALF * K * 2;
    const size_t tstep = 2 * hstep;
    const unsigned ldsw = (unsigned)wid * 1024u;
    const int aoff = lds_byte(wr * 64 + fr, fq * 8), boff = lds_byte(wc * 32 + fr, fq * 8);
#define PG8_SA(b, h) (((b) * 2 + (h)) * HTB)
#define PG8_SB(b, h) ((4 + (b) * 2 + (h)) * HTB)
#define PG8_STAGE(bufoff, gbase, voff) do { _Pragma("unroll") for (int _i = 0; _i < 2; ++_i) \
        __builtin_amdgcn_global_load_lds((const unsigned*)((const char*)(gbase) + (voff)[_i]), (PG8_LAS unsigned*)(lds + (bufoff) + ldsw + _i * 8192), 16, 0, 0); } while (0)
#define PG8_LDA(dst, b, h) do { _Pragma("unroll") for (int m = 0; m < 4; ++m) _Pragma("unroll") for (int k = 0; k < 2; ++k) dst[m][k] = *(const PG8_LAS bf16x8*)(lds + PG8_SA(b, h) + aoff + m * 2048 + k * 1024); } while (0)
#define PG8_LDB(dst, b, h) do { _Pragma("unroll") for (int n = 0; n < 2; ++n) _Pragma("unroll") for (int k = 0; k < 2; ++k) dst[n][k] = *(const PG8_LAS bf16x8*)(lds + PG8_SB(b, h) + boff + n * 2048 + k * 1024); } while (0)
#define PG8_MMA(ai, bj, At, Bt) do { __builtin_amdgcn_s_setprio(1); _Pragma("unroll") for (int m = 0; m < 4; ++m) _Pragma("unroll") for (int n = 0; n < 2; ++n) _Pragma("unroll") for (int k = 0; k < 2; ++k) \
        acc[ai][bj][m][n] = __builtin_amdgcn_mfma_f32_16x16x32_bf16(Bt[n][k], At[m][k], acc[ai][bj][m][n], 0, 0, 0); __builtin_amdgcn_s_setprio(0); } while (0)
#define PG8_WAIT_V(n) asm volatile("s_waitcnt vmcnt(" #n ")" ::: "memory")
#define PG8_WAIT_L(n) asm volatile("s_waitcnt lgkmcnt(" #n ")" ::: "memory")
#define PG8_BAR __builtin_amdgcn_s_barrier()
#define PG8_SCHED __builtin_amdgcn_sched_barrier(0)
    Unit cur, nxt; int ui = 0;
    if (!S.next(0, cur)) return;
    f32x4 acc[2][2][4][2];
#pragma unroll
    for (int a = 0; a < 2; ++a)
#pragma unroll
        for (int b = 0; b < 2; ++b)
#pragma unroll
            for (int m = 0; m < 4; ++m)
#pragma unroll
                for (int n = 0; n < 2; ++n) acc[a][b][m][n] = (f32x4){0.f, 0.f, 0.f, 0.f};
    bf16x8 At[4][2], B0[2][2], B1[2][2];
    const char* cA = S.pa(g, cur); const char* cB = S.pb(g, cur);
    S.a_ready(cur);
    if constexpr (SP2) {
        PG8_STAGE(PG8_SB(0, 0), cB, voffB); PG8_STAGE(PG8_SB(0, 1), cB + hstep, voffB); PG8_STAGE(PG8_SA(0, 0), cA, voffA); PG8_STAGE(PG8_SA(0, 1), cA + hstep, voffA);
        if (wr == 1) PG8_BAR;
        PG8_WAIT_V(2); PG8_BAR;
        PG8_STAGE(PG8_SB(1, 0), cB + kstep, voffB); PG8_STAGE(PG8_SA(1, 0), cA + kstep, voffA); PG8_STAGE(PG8_SB(1, 1), cB + hstep + kstep, voffB);
        PG8_WAIT_V(6); PG8_BAR;
    } else {
        PG8_STAGE(PG8_SB(0, 0), cB, voffB); PG8_STAGE(PG8_SA(0, 0), cA, voffA); PG8_STAGE(PG8_SB(0, 1), cB + hstep, voffB); PG8_STAGE(PG8_SA(0, 1), cA + hstep, voffA);
        if (wr == 1) PG8_BAR;
        PG8_WAIT_V(4); PG8_BAR;
        PG8_STAGE(PG8_SB(1, 0), cB + kstep, voffB); PG8_STAGE(PG8_SA(1, 0), cA + kstep, voffA); PG8_STAGE(PG8_SB(1, 1), cB + hstep + kstep, voffB);
        PG8_WAIT_V(6); PG8_BAR;
    }
    for (;;) {
        const bool has_next = S.next(ui + 1, nxt);
        const char* nA = has_next ? S.pa(g, nxt) : cA; const char* nB = has_next ? S.pb(g, nxt) : cB;
        for (int t = 0; t < nt; t += 2) {
            const bool last = (t == nt - 2);
            const char* a1 = cA + (size_t)(t + 1) * kstep;
            const char* a2 = last ? nA : cA + (size_t)(t + 2) * kstep; const char* b2 = last ? nB : cB + (size_t)(t + 2) * kstep;
            const char* a3 = a2 + kstep; const char* b3 = b2 + kstep;
            if (last && has_next) S.a_ready(nxt);
            if constexpr (SP2) {
            PG8_LDB(B0, 0, 0); PG8_LDB(B1, 0, 1); PG8_SCHED; PG8_LDA(At, 0, 0); PG8_STAGE(PG8_SA(1, 1), a1 + hstep, voffA);
            PG8_WAIT_V(8); PG8_WAIT_L(0); PG8_BAR; PG8_MMA(0, 0, At, B0); PG8_MMA(0, 1, At, B1); PG8_BAR; PG8_SCHED;
            PG8_LDA(At, 0, 1); PG8_STAGE(PG8_SB(0, 0), b2, voffB); PG8_STAGE(PG8_SB(0, 1), b2 + hstep, voffB); PG8_STAGE(PG8_SA(0, 0), a2, voffA);
            PG8_WAIT_V(8); PG8_WAIT_L(0); PG8_BAR; PG8_MMA(1, 0, At, B0); PG8_MMA(1, 1, At, B1); PG8_BAR; PG8_SCHED;
            PG8_LDB(B0, 1, 0); PG8_LDB(B1, 1, 1); PG8_SCHED; PG8_LDA(At, 1, 0); PG8_STAGE(PG8_SA(0, 1), a2 + hstep, voffA);
            PG8_WAIT_V(8); PG8_WAIT_L(0); PG8_BAR; PG8_MMA(0, 0, At, B0); PG8_MMA(0, 1, At, B1); PG8_BAR; PG8_SCHED;
            PG8_LDA(At, 1, 1); PG8_STAGE(PG8_SB(1, 0), b3, voffB); PG8_STAGE(PG8_SB(1, 1), b3 + hstep, voffB); PG8_STAGE(PG8_SA(1, 0), a3, voffA);
            PG8_WAIT_V(8); PG8_WAIT_L(0); PG8_BAR; PG8_MMA(1, 0, At, B0); PG8_MMA(1, 1, At, B1); PG8_BAR; PG8_SCHED;
            } else {
            PG8_LDB(B0, 0, 0); PG8_SCHED; PG8_LDA(At, 0, 0); PG8_STAGE(PG8_SA(1, 1), a1 + hstep, voffA);
            PG8_WAIT_L(8); PG8_BAR; PG8_WAIT_L(0); PG8_MMA(0, 0, At, B0); PG8_BAR; PG8_SCHED;
            PG8_LDB(B1, 0, 1); PG8_STAGE(PG8_SB(0, 0), b2, voffB);
            PG8_BAR; PG8_WAIT_L(0); PG8_MMA(0, 1, At, B1); PG8_BAR;
            PG8_LDA(At, 0, 1); PG8_STAGE(PG8_SA(0, 0), a2, voffA);
            PG8_BAR; PG8_WAIT_L(0); PG8_MMA(1, 0, At, B0); PG8_BAR; PG8_SCHED;
            PG8_STAGE(PG8_SB(0, 1), b2 + hstep, voffB);
            PG8_WAIT_V(6); PG8_BAR; PG8_MMA(1, 1, At, B1); PG8_BAR;
            PG8_LDB(B0, 1, 0); PG8_SCHED; PG8_LDA(At, 1, 0); PG8_STAGE(PG8_SA(0, 1), a2 + hstep, voffA);
            PG8_WAIT_L(8); PG8_BAR; PG8_WAIT_L(0); PG8_MMA(0, 0, At, B0); PG8_BAR; PG8_SCHED;
            PG8_LDB(B1, 1, 1); PG8_STAGE(PG8_SB(1, 0), b3, voffB);
            PG8_BAR; PG8_WAIT_L(0); PG8_MMA(0, 1, At, B1); PG8_BAR;
            PG8_LDA(At, 1, 1); PG8_STAGE(PG8_SA(1, 0), a3, voffA);
            PG8_BAR; PG8_WAIT_L(0); PG8_MMA(1, 0, At, B0); PG8_BAR; PG8_SCHED;
            PG8_STAGE(PG8_SB(1, 1), b3 + hstep, voffB);
            PG8_WAIT_V(6); PG8_BAR; PG8_MMA(1, 1, At, B1); PG8_BAR;
            }
        }
        if constexpr (ALIGN_EPI) { if (wr == 0) PG8_BAR; }
        if constexpr (!Epi::AFTER_DRAIN) { E(acc, cur, wr, wc, fr, fq); S.done(cur); }
        if (!has_next) break;
#pragma unroll
        for (int a = 0; a < 2; ++a)
#pragma unroll
            for (int b = 0; b < 2; ++b)
#pragma unroll
                for (int m = 0; m < 4; ++m)
#pragma unroll
                    for (int n = 0; n < 2; ++n) acc[a][b][m][n] = (f32x4){0.f, 0.f, 0.f, 0.f};
        cur = nxt; cA = nA; cB = nB; ++ui;
        if constexpr (ALIGN_EPI) { if (wr == 1) PG8_BAR; }
    }
    PG8_WAIT_V(0);
    if constexpr (!ALIGN_EPI) { if (wr == 0) PG8_BAR; }
    PG8_BAR;
    if constexpr (Epi::AFTER_DRAIN) { E.fused(acc, cur, wr, wc, fr, fq, lds, wid, lane); S.done(cur); }
#undef PG8_SA
#undef PG8_SB
#undef PG8_STAGE
#undef PG8_LDA
#undef PG8_LDB
#undef PG8_MMA
#undef PG8_WAIT_V
#undef PG8_WAIT_L
#undef PG8_BAR
#undef PG8_SCHED
}
}

constexpr int NWAVES = 8;
#ifndef MK_ONE_LAUNCH
#define MK_ONE_LAUNCH 1
#endif
constexpr int N_PHASES = 12;

constexpr int BATCH = 8, SEQ = 2048, D = 1024, M = BATCH * SEQ;
constexpr int IN_COLS = 9472, N1 = 7424;
constexpr int DFF = 2816, NUP = 2 * DFF;
constexpr int MH = M / 2;
constexpr float EPS = 1e-6f, GN_EPS = 64e-5f;

constexpr size_t MiB = 1u << 20;
constexpr size_t WS_CTL = 0;
constexpr size_t WS_W1 = 1 * MiB, WS_W3 = 16 * MiB, WS_WOUT = 24 * MiB, WS_WUP = 26 * MiB, WS_WDN = 37 * MiB, WS_LORA = 43 * MiB;
constexpr size_t WS_Q = 44 * MiB, WS_KF = 76 * MiB, WS_HG = 108 * MiB, WS_R = 140 * MiB, WS_K = 172 * MiB, WS_LZ = 204 * MiB, WS_VI = 212 * MiB;
constexpr size_t WS_SS1 = 244 * MiB, WS_SS3 = 252 * MiB;
constexpr size_t WS_SCR = 76 * MiB;
constexpr size_t WS_MRG = WS_Q;
constexpr size_t WS_MIX = 76 * MiB;
constexpr size_t WS_HB = WS_Q;
constexpr size_t WS_HU = 76 * MiB;
constexpr size_t WS_ACT = 164 * MiB;
constexpr size_t WS_END = 256 * MiB;
constexpr size_t OUT_XN = 0, OUT_V = 32 * MiB;

constexpr int LDS_BYTES = 147456;

#define GAS __attribute__((address_space(1)))
#define LAS __attribute__((address_space(3)))
typedef unsigned short bf16;
typedef unsigned v4u __attribute__((ext_vector_type(4)));
typedef unsigned v2u __attribute__((ext_vector_type(2)));
typedef float f32x4 __attribute__((ext_vector_type(4)));
typedef float f32x2 __attribute__((ext_vector_type(2)));
typedef short bf16x8 __attribute__((ext_vector_type(8)));
#define LDS_WAIT() asm volatile("s_waitcnt lgkmcnt(0)" ::: "memory")
#define VM_WAIT() asm volatile("s_waitcnt vmcnt(0)" ::: "memory")
__device__ __forceinline__ unsigned f2bf(float f) { unsigned u = __builtin_bit_cast(unsigned, f); return (u + 0x7fffu + ((u >> 16) & 1u)) >> 16; }
__device__ __forceinline__ unsigned pk2(float lo, float hi) { return f2bf(lo) | (f2bf(hi) << 16); }
__device__ __forceinline__ float bf_lo(unsigned u) { return __builtin_bit_cast(float, u << 16); }
__device__ __forceinline__ float bf_hi(unsigned u) { return __builtin_bit_cast(float, u & 0xffff0000u); }
__device__ __forceinline__ float bf1(unsigned short u) { return __builtin_bit_cast(float, (unsigned)u << 16); }
__device__ __forceinline__ float h1(unsigned short u) { return (float)__builtin_bit_cast(_Float16, u); }
__device__ __forceinline__ float fsig(float x) { return __builtin_amdgcn_rcpf(1.0f + __expf(-x)); }
__device__ __forceinline__ float wave_sum(float v) {
#pragma unroll
    for (int o = 1; o < 64; o <<= 1) v += __shfl_xor(v, o);
    return v;
}
template <int CTRL> __device__ __forceinline__ float dpp_f(float x) { return __builtin_bit_cast(float, __builtin_amdgcn_mov_dpp(__builtin_bit_cast(int, x), CTRL, 0xf, 0xf, false)); }
__device__ __forceinline__ float red16(float x) {
    x += dpp_f<0x128>(x); x += dpp_f<0x124>(x); x += dpp_f<0x122>(x); x += dpp_f<0x121>(x); return x;
}

struct Frame {
    LAS unsigned char* lds;
    int tid, lane, wave, G, bid;
    const float* in[26]; float* out; unsigned char* ws;
};

__device__ __forceinline__ void p0_tr_item(const float* W, int ldw, int n0, int K, bf16* WT, int r0, int nblk, LAS float* scr, int item, int lane) {
    const int kb = item / nblk, nb = item % nblk, k0 = 64 * kb, nn = 32 * nb;
#pragma unroll 8
    for (int i = 0; i < 32; ++i) { const int kk = 2 * i + (lane >> 5); scr[kk * 33 + (lane & 31)] = W[(size_t)(k0 + kk) * ldw + n0 + nn + (lane & 31)]; }
    LDS_WAIT(); asm volatile("" ::: "memory");
    const int c = lane & 7;
#pragma unroll
    for (int j = 0; j < 4; ++j) { const int n = (lane >> 3) + 8 * j; const LAS float* s = scr + (8 * c) * 33 + n;
        v4u o; o.x = pk2(s[0 * 33], s[1 * 33]); o.y = pk2(s[2 * 33], s[3 * 33]); o.z = pk2(s[4 * 33], s[5 * 33]); o.w = pk2(s[6 * 33], s[7 * 33]);
        *(GAS v4u*)(WT + (size_t)(r0 + nn + n) * K + k0 + 8 * c) = o; }
    LDS_WAIT(); asm volatile("" ::: "memory");
}
__device__ __forceinline__ void rms_row_to_bf16(int lane, const float* xrow, const float* g, bf16* orow) {
    const GAS f32x4* xr = (const GAS f32x4*)xrow + lane; const GAS f32x4* gr = (const GAS f32x4*)g + lane;
    f32x4 v[4]; float s = 0.f;
#pragma unroll
    for (int j = 0; j < 4; ++j) { v[j] = xr[64 * j]; s += (v[j].x * v[j].x + v[j].y * v[j].y) + (v[j].z * v[j].z + v[j].w * v[j].w); }
    const float rstd = __builtin_amdgcn_rsqf(wave_sum(s) * (1.f / D) + EPS);
    GAS unsigned long long* o8 = (GAS unsigned long long*)orow + lane;
#pragma unroll
    for (int j = 0; j < 4; ++j) { const f32x4 gg = gr[64 * j]; o8[64 * j] = (unsigned long long)pk2(v[j].x * rstd * gg.x, v[j].y * rstd * gg.y) | ((unsigned long long)pk2(v[j].z * rstd * gg.z, v[j].w * rstd * gg.w) << 32); }
}
__device__ __forceinline__ void p0_prologue(Frame& F) {
    LAS float* scr = (LAS float*)(F.lds + F.wave * 16384);
    const int gw = F.bid * NWAVES + F.wave, NGW = F.G * NWAVES;
    const float* w_in = F.in[2];
    bf16* W1 = (bf16*)(F.ws + WS_W1); bf16* W3 = (bf16*)(F.ws + WS_W3); bf16* WO = (bf16*)(F.ws + WS_WOUT); bf16* WU = (bf16*)(F.ws + WS_WUP); bf16* WD = (bf16*)(F.ws + WS_WDN);
    bf16* L2 = (bf16*)(F.ws + WS_LORA);
    constexpr int I_A = 16 * (N1 / 32), I_G = 16 * 32, I_UP = 16 * (NUP / 32), I_DN = (DFF / 64) * 32, I_L64 = 32, I_L128 = 64;
    constexpr int NITEMS = I_A + 5 * I_G + I_UP + I_DN + 2 * I_L64 + I_L128;
    for (int it = gw; it < NITEMS; it += NGW) {
        int r = it;
        if (r < I_A) { p0_tr_item(w_in, IN_COLS, 0, D, W1, 0, N1 / 32, scr, r, F.lane); continue; } r -= I_A;
        if (r < I_G) { p0_tr_item(w_in, IN_COLS, N1, D, W3, 0, 32, scr, r, F.lane); continue; } r -= I_G;
        if (r < I_G) { p0_tr_item(F.in[5], D, 0, D, W3, 1024, 32, scr, r, F.lane); continue; } r -= I_G;
        if (r < I_G) { p0_tr_item(w_in, IN_COLS, N1 + 1024, D, W3, 2048, 32, scr, r, F.lane); continue; } r -= I_G;
        if (r < I_G) { p0_tr_item(F.in[17], D, 0, D, W3, 3072, 32, scr, r, F.lane); continue; } r -= I_G;
        if (r < I_G) { p0_tr_item(F.in[18], D, 0, D, WO, 0, 32, scr, r, F.lane); continue; } r -= I_G;
        if (r < I_UP) { p0_tr_item(F.in[21], NUP, 0, D, WU, 0, NUP / 32, scr, r, F.lane); continue; } r -= I_UP;
        if (r < I_DN) { p0_tr_item(F.in[24], D, 0, DFF, WD, 0, 32, scr, r, F.lane); continue; } r -= I_DN;
        if (r < I_L64) { p0_tr_item(F.in[8], D, 0, 64, L2, 0, 32, scr, r, F.lane); continue; } r -= I_L64;
        if (r < I_L64) { p0_tr_item(F.in[10], D, 0, 64, L2 + 65536, 0, 32, scr, r, F.lane); continue; } r -= I_L64;
        p0_tr_item(F.in[11], D, 0, 128, L2 + 131072, 0, 32, scr, r, F.lane);
    }
    bf16* XN = (bf16*)((unsigned char*)F.out + OUT_XN);
    for (int m = gw; m < M; m += NGW) rms_row_to_bf16(F.lane, F.in[0] + (size_t)m * D, F.in[1], XN + (size_t)m * D);
}

__device__ __forceinline__ void rwkv_phase(Frame& F, int bh) {
    const int b = bh >> 4, h = bh & 15, tid = F.tid, lane = F.lane, wv = F.wave;
    LAS unsigned char* L = F.lds;
    constexpr int RAW_OFF = 0;
    constexpr int LA_OFF = 29696;
    constexpr int RKV_OFF = 46592;
    constexpr int WAG_OFF = 71168;
    constexpr int OPS_OFF = 95744;
    constexpr int SC_OFF = 136704;
    constexpr int Y_OFF = 137216;
    const bf16* Rg = (const bf16*)(F.ws + WS_R); const bf16* Kg = (const bf16*)(F.ws + WS_K); const bf16* Vg = (const bf16*)((unsigned char*)F.out + OUT_V);
    const bf16* LZg = (const bf16*)(F.ws + WS_LZ); bf16* OB = (bf16*)((unsigned char*)F.out + OUT_V);
    const bf16* L2 = (const bf16*)(F.ws + WS_LORA);
    const float* mu = F.in[6];
    const int cp = tid % 224, rh = tid / 224, c0 = 2 * cp;
    float mu0 = 0.f, mu1 = 0.f;
    if (tid < 448) { const int gi = c0 < 64 ? h * 64 + c0 : c0 < 128 ? 1024 + h * 64 + (c0 - 64) : c0 < 192 ? 2048 + h * 64 + (c0 - 128) : 3072 + (c0 - 192); mu0 = mu[gi]; mu1 = mu[gi + 1]; }
    const int tt = wv & 1, nt = wv >> 1, fr = lane & 15, fq = lane >> 4;
    bf16x8 bw[2], ba[2], bg[4];
    { const int n = h * 64 + 16 * nt + fr;
#pragma unroll
      for (int ks = 0; ks < 2; ++ks) { bw[ks] = *(const GAS bf16x8*)(L2 + (size_t)n * 64 + ks * 32 + 8 * fq); ba[ks] = *(const GAS bf16x8*)(L2 + 65536 + (size_t)n * 64 + ks * 32 + 8 * fq); }
#pragma unroll
      for (int ks = 0; ks < 4; ++ks) bg[ks] = *(const GAS bf16x8*)(L2 + 131072 + (size_t)n * 128 + ks * 32 + 8 * fq); }
    const int ncol = h * 64 + 16 * nt + fr;
    const float w0n = F.in[7][ncol], a0n = F.in[9][ncol];
    const int hl = h * 64 + lane;
    const float kkc = F.in[12][hl], kac = F.in[13][hl], rkc = F.in[14][hl], lnw = F.in[15][hl], lnb = F.in[16][hl];
    const int l = tid & 15, p = tid >> 4;
    float S0[4] = {0.f, 0.f, 0.f, 0.f}, S1[4] = {0.f, 0.f, 0.f, 0.f};
    v4u pre[4];
    const size_t rowbase = (size_t)b * SEQ;
#define RWKV_PREFETCH(T0) do { _Pragma("unroll") for (int j = 0; j < 4; ++j) { const int q = tid + 512 * j; v4u val = (v4u){0u, 0u, 0u, 0u}; \
        if (q < 32 * 56) { const int row = q / 56, pc = q % 56; const size_t gr = rowbase + (T0) + row; \
            const bf16* src = pc < 8 ? Rg + gr * D + h * 64 + 8 * pc : pc < 16 ? Kg + gr * D + h * 64 + 8 * (pc - 8) : pc < 24 ? Vg + gr * D + h * 64 + 8 * (pc - 16) : LZg + gr * 256 + 8 * (pc - 24); \
            val = *(const GAS v4u*)src; } \
        pre[j] = val; } } while (0)
    if (tid < 224) ((LAS unsigned*)(L + RAW_OFF))[tid] = 0u;
    RWKV_PREFETCH(0);
    for (int c = 0; c < SEQ / 32; ++c) {
        const int t0 = 32 * c;
#pragma unroll
        for (int j = 0; j < 4; ++j) { const int q = tid + 512 * j; if (q < 32 * 56) *(LAS v4u*)(L + RAW_OFF + 896 + q * 16) = pre[j]; }
        __syncthreads();
        if (c + 1 < SEQ / 32) RWKV_PREFETCH(t0 + 32);
        if (tid < 448) {
            const LAS unsigned* raw = (const LAS unsigned*)(L + RAW_OFF) + cp;
            unsigned up = raw[(16 * rh) * 224];
            float zp0 = bf_lo(up), zp1 = bf_hi(up);
#pragma unroll 4
            for (int ii = 0; ii < 16; ++ii) { const int i = 16 * rh + ii; const unsigned u = raw[(i + 1) * 224]; const float z0 = bf_lo(u), z1 = bf_hi(u);
                float x0 = z0 + mu0 * (zp0 - z0), x1 = z1 + mu1 * (zp1 - z1); zp0 = z0; zp1 = z1;
                if (c0 < 192) { *(LAS f32x2*)(L + RKV_OFF + (((c0 >> 6) * 32 + i) * 64 + (c0 & 63)) * 4) = (f32x2){x0, x1}; }
                else { if (c0 < 256) { const float e0 = __expf(2.f * x0), e1 = __expf(2.f * x1); x0 = 1.f - 2.f * __builtin_amdgcn_rcpf(e0 + 1.f); x1 = 1.f - 2.f * __builtin_amdgcn_rcpf(e1 + 1.f); }
                       else if (c0 >= 320) { x0 = fsig(x0); x1 = fsig(x1); }
                       *(LAS unsigned*)(L + LA_OFF + (i * 264 + (c0 - 192)) * 2) = pk2(x0, x1); } }
        }
        __syncthreads();
        if (tid < 224) ((LAS unsigned*)(L + RAW_OFF))[tid] = ((const LAS unsigned*)(L + RAW_OFF))[32 * 224 + tid];
        { pg8::f32x4 cw = {0.f, 0.f, 0.f, 0.f}, ca = cw, cgt = cw;
          const LAS unsigned char* arow = L + LA_OFF + ((16 * tt + fr) * 264 + 8 * fq) * 2;
#pragma unroll
          for (int ks = 0; ks < 2; ++ks) { const bf16x8 af = *(const LAS bf16x8*)(arow + (ks * 32) * 2); cw = __builtin_amdgcn_mfma_f32_16x16x32_bf16(af, bw[ks], cw, 0, 0, 0); }
#pragma unroll
          for (int ks = 0; ks < 2; ++ks) { const bf16x8 af = *(const LAS bf16x8*)(arow + (64 + ks * 32) * 2); ca = __builtin_amdgcn_mfma_f32_16x16x32_bf16(af, ba[ks], ca, 0, 0, 0); }
#pragma unroll
          for (int ks = 0; ks < 4; ++ks) { const bf16x8 af = *(const LAS bf16x8*)(arow + (128 + ks * 32) * 2); cgt = __builtin_amdgcn_mfma_f32_16x16x32_bf16(af, bg[ks], cgt, 0, 0, 0); }
#pragma unroll
          for (int j = 0; j < 4; ++j) { const int i = 16 * tt + 4 * fq + j, n = 16 * nt + fr;
              const float wp = w0n + cw[j];
              const float wl = fminf(wp, 0.f) - __logf(1.f + __expf(-fabsf(wp))) - 0.5f;
              const float dec = __expf(-__expf(wl));
              LAS float* wag = (LAS float*)(L + WAG_OFF);
              wag[(0 * 32 + i) * 64 + n] = dec; wag[(1 * 32 + i) * 64 + n] = fsig(a0n + ca[j]); wag[(2 * 32 + i) * 64 + n] = cgt[j]; } }
        __syncthreads();
        { const LAS float* rkv = (const LAS float*)(L + RKV_OFF); const LAS float* wag = (const LAS float*)(L + WAG_OFF); LAS float* ops = (LAS float*)(L + OPS_OFF); LAS float* sc = (LAS float*)(L + SC_OFF);
#pragma unroll
          for (int jj = 0; jj < 4; ++jj) { const int i = 4 * wv + jj;
              const float r = rkv[(0 * 32 + i) * 64 + lane], kr = rkv[(1 * 32 + i) * 64 + lane], w = wag[(0 * 32 + i) * 64 + lane], a = wag[(1 * 32 + i) * 64 + lane];
              float kk = kr * kkc; const float nrm = __builtin_sqrtf(wave_sum(kk * kk)); kk = kk / fmaxf(nrm, 1e-12f);
              const float k2 = kr * (1.f + (a - 1.f) * kac);
              const float bv = kk * a;
              const float sbr = wave_sum(bv * r), skr = wave_sum(k2 * r), sbo = wave_sum(r * k2 * rkc);
              ops[(i * 5 + 0) * 64 + lane] = w; ops[(i * 5 + 1) * 64 + lane] = -kk; ops[(i * 5 + 2) * 64 + lane] = bv; ops[(i * 5 + 3) * 64 + lane] = k2; ops[(i * 5 + 4) * 64 + lane] = w * r;
              if (lane == 0) { sc[i * 4 + 0] = sbr; sc[i * 4 + 1] = skr; sc[i * 4 + 2] = sbo; } } }
        __syncthreads();
        { const LAS float* ops = (const LAS float*)(L + OPS_OFF) + 4 * l; const LAS float* vv = (const LAS float*)(L + RKV_OFF) + 2 * 32 * 64 + 2 * p; const LAS float* sc = (const LAS float*)(L + SC_OFF); LAS float* Y = (LAS float*)(L + Y_OFF) + 2 * p;
#pragma unroll 4
          for (int i = 0; i < 32; ++i) {
              const f32x4 w4 = *(const LAS f32x4*)(ops + i * 320), a4 = *(const LAS f32x4*)(ops + i * 320 + 64), b4 = *(const LAS f32x4*)(ops + i * 320 + 128), k4 = *(const LAS f32x4*)(ops + i * 320 + 192), q4 = *(const LAS f32x4*)(ops + i * 320 + 256);
              const f32x2 v2 = *(const LAS f32x2*)(vv + i * 64); const f32x2 s2 = *(const LAS f32x2*)(sc + i * 4);
              float sa0 = (S0[0] * a4.x + S0[1] * a4.y) + (S0[2] * a4.z + S0[3] * a4.w), sa1 = (S1[0] * a4.x + S1[1] * a4.y) + (S1[2] * a4.z + S1[3] * a4.w);
              float yq0 = (S0[0] * q4.x + S0[1] * q4.y) + (S0[2] * q4.z + S0[3] * q4.w), yq1 = (S1[0] * q4.x + S1[1] * q4.y) + (S1[2] * q4.z + S1[3] * q4.w);
              sa0 = red16(sa0); sa1 = red16(sa1); yq0 = red16(yq0); yq1 = red16(yq1);
#pragma unroll
              for (int j = 0; j < 4; ++j) { S0[j] = S0[j] * w4[j] + sa0 * b4[j] + v2.x * k4[j]; S1[j] = S1[j] * w4[j] + sa1 * b4[j] + v2.y * k4[j]; }
              if (l == 0) *(LAS f32x2*)(Y + i * 64) = (f32x2){yq0 + sa0 * s2.x + v2.x * s2.y, yq1 + sa1 * s2.x + v2.y * s2.y};
          } }
        __syncthreads();
        { const LAS float* Y = (const LAS float*)(L + Y_OFF); const LAS float* sc = (const LAS float*)(L + SC_OFF); const LAS float* vv = (const LAS float*)(L + RKV_OFF) + 2 * 32 * 64; const LAS float* gg = (const LAS float*)(L + WAG_OFF) + 2 * 32 * 64;
#pragma unroll
          for (int jj = 0; jj < 4; ++jj) { const int i = 4 * wv + jj; const float y = Y[i * 64 + lane];
              const float mean = wave_sum(y) * (1.f / 64.f), d = y - mean, var = wave_sum(d * d) * (1.f / 64.f);
              const float yn = d * __builtin_amdgcn_rsqf(var + GN_EPS) * lnw + lnb;
              const float o = (yn + sc[i * 4 + 2] * vv[i * 64 + lane]) * gg[i * 64 + lane];
              OB[(rowbase + t0 + i) * D + hl] = (bf16)f2bf(o); } }
        __syncthreads();
    }
}

__device__ __forceinline__ void hgrn_phase(Frame& F, int bh) {
    const int b = bh >> 3, h = bh & 7, tid = F.tid, lane = F.lane, w = F.wave, fr = lane & 15, fq = lane >> 4;
    LAS unsigned char* L = F.lds;
    constexpr int QIN = 0, KIN = 8704, QDEC = 17408, KDT = 26112, VT = 36352, SCM = 46592, SB = 49152, OBUF = 83968, SEG = 100864, DEC = 102912;
    const bf16* Qg = (const bf16*)(F.ws + WS_Q); const bf16* KFg = (const bf16*)(F.ws + WS_KF); const bf16* HGg = (const bf16*)(F.ws + WS_HG); bf16* VIg = (bf16*)(F.ws + WS_VI);
    const float* gn = F.in[4];
    const int k = tid & 127, q = tid >> 7;
    const size_t rowbase = (size_t)b * SEQ; const int colb = h * 128;
    for (int u = tid; u < 34816 / 16; u += 512) *(LAS v4u*)(L + SB + u * 16) = (v4u){0u, 0u, 0u, 0u};
    pg8::f32x4 Sacc[8];
#pragma unroll
    for (int t = 0; t < 8; ++t) Sacc[t] = (pg8::f32x4){0.f, 0.f, 0.f, 0.f};
    unsigned short pq[8], pk[8], pv[8];
#define HGRN_PREFETCH(T0) do { _Pragma("unroll") for (int j = 0; j < 8; ++j) { const size_t off = (rowbase + (T0) + 8 * q + j) * D + colb + k; pq[j] = Qg[off]; pk[j] = KFg[off]; pv[j] = VIg[off]; } } while (0)
    HGRN_PREFETCH(0);
    const float g0 = gn[colb + lane], g1 = gn[colb + 64 + lane];
    __syncthreads();
    for (int c = 0; c < SEQ / 32; ++c) {
        const int t0 = 32 * c;
        float qf[8], kf[8], pl[8];
        { float run = 0.f;
#pragma unroll
          for (int j = 0; j < 8; ++j) { qf[j] = bf1(pq[j]); kf[j] = h1(pk[j]); run += __logf(1.f - kf[j]); pl[j] = run; }
          ((LAS float*)(L + SEG))[q * 128 + k] = run;
          v4u o; o.x = (unsigned)pv[0] | ((unsigned)pv[1] << 16); o.y = (unsigned)pv[2] | ((unsigned)pv[3] << 16); o.z = (unsigned)pv[4] | ((unsigned)pv[5] << 16); o.w = (unsigned)pv[6] | ((unsigned)pv[7] << 16);
          *(LAS v4u*)(L + VT + (k * 40 + 8 * q) * 2) = o; }
        __syncthreads();
        if (c + 1 < SEQ / 32) HGRN_PREFETCH(t0 + 32);
        { const LAS float* seg = (const LAS float*)(L + SEG);
          const float s0 = seg[k], s1 = seg[128 + k], s2 = seg[256 + k], s3 = seg[384 + k];
          const float offs = q == 0 ? 0.f : q == 1 ? s0 : q == 2 ? s0 + s1 : s0 + s1 + s2;
          const float bref = s0 + s1, blast = (s0 + s1) + (s2 + s3);
          const float Elr = __expf(blast - bref), Eref = __expf(bref);
          if (q == 3) ((LAS float*)(L + DEC))[k] = Elr * Eref;
          unsigned short kd[8];
#pragma unroll
          for (int j = 0; j < 8; ++j) { const float bj = offs + pl[j]; const float e1 = __expf(bj - bref), r1 = __builtin_amdgcn_rcpf(e1); const int i = 8 * q + j;
              *(LAS unsigned short*)(L + QIN + (i * 136 + k) * 2) = (unsigned short)f2bf(qf[j] * e1);
              *(LAS unsigned short*)(L + KIN + (i * 136 + k) * 2) = (unsigned short)f2bf(kf[j] * r1);
              *(LAS unsigned short*)(L + QDEC + (i * 136 + k) * 2) = (unsigned short)f2bf(qf[j] * e1 * Eref);
              kd[j] = (unsigned short)f2bf(kf[j] * Elr * r1); }
          v4u o; o.x = (unsigned)kd[0] | ((unsigned)kd[1] << 16); o.y = (unsigned)kd[2] | ((unsigned)kd[3] << 16); o.z = (unsigned)kd[4] | ((unsigned)kd[5] << 16); o.w = (unsigned)kd[6] | ((unsigned)kd[7] << 16);
          *(LAS v4u*)(L + KDT + (k * 40 + 8 * q) * 2) = o; }
        __syncthreads();
        pg8::f32x4 oacc[2];
#pragma unroll
        for (int t = 0; t < 2; ++t) { const int tile = 2 * w + t, ti = tile >> 3, tv = tile & 7; pg8::f32x4 a = {0.f, 0.f, 0.f, 0.f};
#pragma unroll
            for (int ks = 0; ks < 4; ++ks) { const bf16x8 af = *(const LAS bf16x8*)(L + QDEC + ((16 * ti + fr) * 136 + ks * 32 + 8 * fq) * 2); const bf16x8 bfm = *(const LAS bf16x8*)(L + SB + ((16 * tv + fr) * 136 + ks * 32 + 8 * fq) * 2);
                a = __builtin_amdgcn_mfma_f32_16x16x32_bf16(af, bfm, a, 0, 0, 0); }
            oacc[t] = a; }
        if (w < 4) { const int ti = w >> 1, tj = w & 1; pg8::f32x4 a = {0.f, 0.f, 0.f, 0.f};
            if (tj <= ti) {
#pragma unroll
                for (int ks = 0; ks < 4; ++ks) { const bf16x8 af = *(const LAS bf16x8*)(L + QIN + ((16 * ti + fr) * 136 + ks * 32 + 8 * fq) * 2); const bf16x8 bfm = *(const LAS bf16x8*)(L + KIN + ((16 * tj + fr) * 136 + ks * 32 + 8 * fq) * 2);
                    a = __builtin_amdgcn_mfma_f32_16x16x32_bf16(af, bfm, a, 0, 0, 0); } }
#pragma unroll
            for (int j = 0; j < 4; ++j) { const int i = 16 * ti + 4 * fq + j, jj = 16 * tj + fr; const float s = (jj <= i) ? a[j] : 0.f; *(LAS unsigned short*)(L + SCM + (i * 40 + jj) * 2) = (unsigned short)f2bf(s); } }
        __syncthreads();
        { bf16x8 vfr[8];
#pragma unroll
          for (int tv = 0; tv < 8; ++tv) vfr[tv] = *(const LAS bf16x8*)(L + VT + ((16 * tv + fr) * 40 + 8 * fq) * 2);
#pragma unroll
          for (int t = 0; t < 2; ++t) { const int tile = 2 * w + t, ti = tile >> 3, tv = tile & 7;
              const bf16x8 af = *(const LAS bf16x8*)(L + SCM + ((16 * ti + fr) * 40 + 8 * fq) * 2);
              const bf16x8 bfm = *(const LAS bf16x8*)(L + VT + ((16 * tv + fr) * 40 + 8 * fq) * 2);
              oacc[t] = __builtin_amdgcn_mfma_f32_16x16x32_bf16(af, bfm, oacc[t], 0, 0, 0);
#pragma unroll
              for (int j = 0; j < 4; ++j) ((LAS float*)(L + OBUF))[(16 * ti + 4 * fq + j) * 132 + 16 * tv + fr] = oacc[t][j]; }
          const pg8::f32x4 d4 = *(const LAS pg8::f32x4*)(L + DEC + (16 * w + 4 * fq) * 4);
          const bf16x8 kfrag = *(const LAS bf16x8*)(L + KDT + ((16 * w + fr) * 40 + 8 * fq) * 2);
#pragma unroll
          for (int tv = 0; tv < 8; ++tv) { pg8::f32x4 s = Sacc[tv] * d4; s = __builtin_amdgcn_mfma_f32_16x16x32_bf16(kfrag, vfr[tv], s, 0, 0, 0); Sacc[tv] = s;
              v2u o; o.x = pk2(s[0], s[1]); o.y = pk2(s[2], s[3]); *(LAS v2u*)(L + SB + ((16 * tv + fr) * 136 + 16 * w + 4 * fq) * 2) = o; } }
        __syncthreads();
        { const LAS float* ob = (const LAS float*)(L + OBUF);
#pragma unroll
          for (int jj = 0; jj < 4; ++jj) { const int i = 4 * w + jj; const float o0 = ob[i * 132 + lane], o1 = ob[i * 132 + 64 + lane];
              const float rstd = __builtin_amdgcn_rsqf(wave_sum(o0 * o0 + o1 * o1) * (1.f / 128.f) + EPS);
              const size_t off = (rowbase + t0 + i) * D + colb + lane;
              VIg[off] = (bf16)f2bf(o0 * rstd * g0 * bf1(HGg[off])); VIg[off + 64] = (bf16)f2bf(o1 * rstd * g1 * bf1(HGg[off + 64])); } }
    }
}

__device__ __forceinline__ void p5_rows(Frame& F) {
    const int gw = F.bid * NWAVES + F.wave, NGW = F.G * NWAVES, lane = F.lane;
    const float* MIX = (const float*)(F.ws + WS_MIX); const float* SSP = (const float*)(F.ws + WS_SS1); bf16* HB = (bf16*)(F.ws + WS_HB);
    const GAS f32x4* g1 = (const GAS f32x4*)F.in[19] + lane; const GAS f32x4* g2 = (const GAS f32x4*)F.in[20] + lane;
    for (int m = gw; m < M; m += NGW) {
        const float sp = lane < 16 ? SSP[(size_t)m * 16 + lane] : 0.f;
        const float rstd1 = __builtin_amdgcn_rsqf(wave_sum(sp) * (1.f / D) + EPS);
        const GAS f32x4* mr = (const GAS f32x4*)(MIX + (size_t)m * D) + lane; const GAS f32x4* xr = (const GAS f32x4*)(F.in[0] + (size_t)m * D) + lane; GAS f32x4* hr = (GAS f32x4*)(F.out + (size_t)m * D) + lane;
        f32x4 hv[4]; float s = 0.f;
#pragma unroll
        for (int j = 0; j < 4; ++j) { hv[j] = xr[64 * j] + mr[64 * j] * rstd1 * g1[64 * j]; hr[64 * j] = hv[j]; s += (hv[j].x * hv[j].x + hv[j].y * hv[j].y) + (hv[j].z * hv[j].z + hv[j].w * hv[j].w); }
        const float rstd2 = __builtin_amdgcn_rsqf(wave_sum(s) * (1.f / D) + EPS);
        GAS unsigned long long* o8 = (GAS unsigned long long*)(HB + (size_t)m * D) + lane;
#pragma unroll
        for (int j = 0; j < 4; ++j) { const f32x4 gg = g2[64 * j]; o8[64 * j] = (unsigned long long)pk2(hv[j].x * rstd2 * gg.x, hv[j].y * rstd2 * gg.y) | ((unsigned long long)pk2(hv[j].z * rstd2 * gg.z, hv[j].w * rstd2 * gg.w) << 32); }
    }
}
__device__ __forceinline__ void p11_rows(Frame& F) {
    const int gw = F.bid * NWAVES + F.wave, NGW = F.G * NWAVES, lane = F.lane;
    const float* FFo = (const float*)(F.ws + WS_MIX); const float* SSP = (const float*)(F.ws + WS_SS3);
    const GAS f32x4* g3 = (const GAS f32x4*)F.in[25] + lane;
    for (int m = gw; m < M; m += NGW) {
        const float sp = lane < 16 ? SSP[(size_t)m * 16 + lane] : 0.f;
        const float rstd = __builtin_amdgcn_rsqf(wave_sum(sp) * (1.f / D) + EPS);
        const GAS f32x4* fr = (const GAS f32x4*)(FFo + (size_t)m * D) + lane; GAS f32x4* hr = (GAS f32x4*)(F.out + (size_t)m * D) + lane;
#pragma unroll
        for (int j = 0; j < 4; ++j) hr[64 * j] = hr[64 * j] + fr[64 * j] * rstd * g3[64 * j];
    }
}
__device__ __forceinline__ void conv_phase(Frame& F, int half) {
    const bf16* HU = (const bf16*)(F.ws + WS_HU); bf16* ACT = (bf16*)(F.ws + WS_ACT);
    const float* cw = F.in[22]; const float* cb = F.in[23];
    constexpr int NCG = DFF / 8, NRR = MH / 32, NT = NCG * NRR;
    for (int task = F.bid * 512 + F.tid; task < NT; task += F.G * 512) {
        const int cgi = task % NCG, rr = task / NCG, c = 8 * cgi, r0 = 32 * rr;
        float wg[3][8], wv[3][8], bg[8], bv[8];
#pragma unroll
        for (int e = 0; e < 8; ++e) { bg[e] = cb[c + e]; bv[e] = cb[DFF + c + e];
#pragma unroll
            for (int j = 0; j < 3; ++j) { wg[j][e] = cw[j * NUP + c + e]; wv[j][e] = cw[j * NUP + DFF + c + e]; } }
        float g1[8], g2[8], v1[8], v2[8];
        const bool seq_start = (r0 % SEQ) == 0;
        auto unpack = [](v4u u, float* o) { o[0] = bf_lo(u.x); o[1] = bf_hi(u.x); o[2] = bf_lo(u.y); o[3] = bf_hi(u.y); o[4] = bf_lo(u.z); o[5] = bf_hi(u.z); o[6] = bf_lo(u.w); o[7] = bf_hi(u.w); };
        if (seq_start) {
#pragma unroll
            for (int e = 0; e < 8; ++e) { g1[e] = g2[e] = v1[e] = v2[e] = 0.f; }
        } else { unpack(*(const GAS v4u*)(HU + (size_t)(r0 - 1) * NUP + c), g1); unpack(*(const GAS v4u*)(HU + (size_t)(r0 - 2) * NUP + c), g2);
                 unpack(*(const GAS v4u*)(HU + (size_t)(r0 - 1) * NUP + DFF + c), v1); unpack(*(const GAS v4u*)(HU + (size_t)(r0 - 2) * NUP + DFF + c), v2); }
#pragma unroll 4
        for (int i = 0; i < 32; ++i) { float g0[8], v0[8]; unpack(*(const GAS v4u*)(HU + (size_t)(r0 + i) * NUP + c), g0); unpack(*(const GAS v4u*)(HU + (size_t)(r0 + i) * NUP + DFF + c), v0);
            float o[8];
#pragma unroll
            for (int e = 0; e < 8; ++e) { const float gt = bg[e] + wg[0][e] * g2[e] + wg[1][e] * g1[e] + wg[2][e] * g0[e]; const float vl = bv[e] + wv[0][e] * v2[e] + wv[1][e] * v1[e] + wv[2][e] * v0[e];
                o[e] = gt * fsig(gt) * vl; g2[e] = g1[e]; g1[e] = g0[e]; v2[e] = v1[e]; v1[e] = v0[e]; }
            v4u w; w.x = pk2(o[0], o[1]); w.y = pk2(o[2], o[3]); w.z = pk2(o[4], o[5]); w.w = pk2(o[6], o[7]);
            *(GAS v4u*)(ACT + (size_t)(half * MH + r0 + i) * DFF + c) = w; }
    }
}

struct Args { const float* in[26]; float* out; unsigned char* ws; int ph_lo, ph_hi; };
__global__ void __launch_bounds__(NWAVES * 64, 2) fwd_kernel(Args args) {
    extern __shared__ __attribute__((aligned(16))) unsigned char lds[];
    Frame F;
    F.lds = (LAS unsigned char*)lds; F.tid = threadIdx.x; F.lane = F.tid & 63; F.wave = __builtin_amdgcn_readfirstlane(F.tid >> 6); F.G = gridDim.x; F.bid = blockIdx.x;
#pragma unroll
    for (int i = 0; i < 26; ++i) F.in[i] = args.in[i];
    F.out = args.out; F.ws = args.ws;
    const int lo = args.ph_lo, hi = args.ph_hi;
#ifndef DIAG_SCAN
#define DIAG_SCAN 3
#endif
#ifndef DIAG_MASK
#define DIAG_MASK 0xFFF
#endif
#define IN(k) (((DIAG_MASK >> (k)) & 1) && lo <= (k) && (k) < hi)
#define SEAM(k) do { if (IN(k) && IN((k) + 1)) { cg::this_grid().sync(); } } while (0)
    unsigned char* ws = args.ws; unsigned char* ob = (unsigned char*)args.out;
    if (IN(0)) { p0_prologue(F); } SEAM(0);
    if (IN(1)) {
        pg8::Gemm g{(const pg8::bf16_t*)(ob + OUT_XN), (const pg8::bf16_t*)(ws + WS_W1), M, N1, D}; pg8::StaticOrder S; S.init(M, N1, F.G, F.bid);
        pg8::EpiG1 E{(bf16*)(ws + WS_Q), (bf16*)(ws + WS_KF), (bf16*)(ws + WS_VI), (bf16*)(ws + WS_HG), (bf16*)(ws + WS_R), (bf16*)(ws + WS_K), (bf16*)(ob + OUT_V), (bf16*)(ws + WS_LZ), F.in[3]};
        pg8::gemm_phase<pg8::EpiG1, pg8::StaticOrder, true, true>(F.lds, g, S, E);
    } SEAM(1);
    if (IN(2)) {
        if (F.bid < 128) { if (DIAG_SCAN & 1) rwkv_phase(F, F.bid); } else if (F.bid < 192) { if (DIAG_SCAN & 2) hgrn_phase(F, F.bid - 128); }
    } SEAM(2);
    if (IN(3)) {
        pg8::Gemm g{(const pg8::bf16_t*)(ob + OUT_XN), (const pg8::bf16_t*)(ws + WS_W3), M, 4096, D};
        pg8::OrderG3 S; S.init(M, D, F.G, F.bid); S.a_xn = (const pg8::bf16_t*)(ob + OUT_XN); S.a_oa = (const pg8::bf16_t*)(ws + WS_VI); S.a_ob = (const pg8::bf16_t*)(ob + OUT_V);
        pg8::EpiG3 E{(pg8::f32x4*)(ws + WS_SCR) + (size_t)F.bid * (2 * 32 * 512), (bf16*)(ws + WS_MRG)};
        pg8::gemm_phase<pg8::EpiG3, pg8::OrderG3, false, true>(F.lds, g, S, E);
    } SEAM(3);
    if (IN(4)) {
        pg8::Gemm g{(const pg8::bf16_t*)(ws + WS_MRG), (const pg8::bf16_t*)(ws + WS_WOUT), M, D, D}; pg8::StaticOrder S; S.init(M, D, F.G, F.bid);
        pg8::EpiF32SS E{(float*)(ws + WS_MIX), (float*)(ws + WS_SS1), D};
        pg8::gemm_phase<pg8::EpiF32SS, pg8::StaticOrder, false, true>(F.lds, g, S, E);
    } SEAM(4);
    if (IN(5)) { p5_rows(F); } SEAM(5);
#pragma unroll 1
    for (int half = 0; half < 2; ++half) {
        if (IN(6 + 2 * half)) {
            pg8::Gemm g{(const pg8::bf16_t*)(ws + WS_HB) + (size_t)half * MH * D, (const pg8::bf16_t*)(ws + WS_WUP), MH, NUP, D}; pg8::StaticOrder S; S.init(MH, NUP, F.G, F.bid);
            pg8::EpiBf16Raw E{(bf16*)(ws + WS_HU), NUP};
            pg8::gemm_phase<pg8::EpiBf16Raw, pg8::StaticOrder, true, true>(F.lds, g, S, E);
        } SEAM(6 + 2 * half);
        if (IN(7 + 2 * half)) { conv_phase(F, half); } SEAM(7 + 2 * half);
    }
    if (IN(10)) {
        pg8::Gemm g{(const pg8::bf16_t*)(ws + WS_ACT), (const pg8::bf16_t*)(ws + WS_WDN), M, D, DFF}; pg8::StaticOrder S; S.init(M, D, F.G, F.bid);
        pg8::EpiF32SS E{(float*)(ws + WS_MIX), (float*)(ws + WS_SS3), D};
        pg8::gemm_phase<pg8::EpiF32SS, pg8::StaticOrder, false, true>(F.lds, g, S, E);
    } SEAM(10);
    if (IN(11)) { p11_rows(F); }
#undef IN
#undef SEAM
}

extern "C" void kernel_launch(void* const* d_in, const int* in_sizes, int n_in, void* d_out, int out_size, void* d_ws, size_t ws_size, hipStream_t stream) {
    static int grid = 0;
    if (grid == 0) {
        if (n_in != 26 || in_sizes[0] != M * D || out_size != M * D || ws_size < WS_END) { fprintf(stderr, "kernel_launch: unexpected shapes (n_in %d, in0 %d, out %d, ws %zu); nothing launched\n", n_in, n_in > 0 ? in_sizes[0] : -1, out_size, ws_size); grid = -1; return; }
        int dev = 0, cus = 0, per_cu = 0;
        if (hipGetDevice(&dev) != hipSuccess || hipDeviceGetAttribute(&cus, hipDeviceAttributeMultiprocessorCount, dev) != hipSuccess) { grid = -1; return; }
        if (hipFuncSetAttribute((const void*)fwd_kernel, hipFuncAttributeMaxDynamicSharedMemorySize, LDS_BYTES) != hipSuccess) { fprintf(stderr, "kernel_launch: hipFuncSetAttribute failed\n"); grid = -1; return; }
        if (hipOccupancyMaxActiveBlocksPerMultiprocessor(&per_cu, (const void*)fwd_kernel, NWAVES * 64, LDS_BYTES) != hipSuccess || per_cu < 1) { fprintf(stderr, "kernel_launch: occupancy query reports %d blocks per CU\n", per_cu); per_cu = 1; }
        (void)hipGetLastError();
        grid = cus;
    }
    if (grid < 0) return;
    Args a{};
    for (int i = 0; i < 26; ++i) a.in[i] = (const float*)d_in[i];
    a.out = (float*)d_out; a.ws = (unsigned char*)d_ws;
#if MK_ONE_LAUNCH
    a.ph_lo = 0; a.ph_hi = N_PHASES;
    void* kargs[] = {&a};
    hipError_t e = hipLaunchCooperativeKernel((const void*)fwd_kernel, dim3(grid), dim3(NWAVES * 64), kargs, LDS_BYTES, stream);
    if (e != hipSuccess) fprintf(stderr, "kernel_launch: cooperative launch failed: %s (grid %d)\n", hipGetErrorString(e), grid);
#else
    for (int ph = 0; ph < N_PHASES; ++ph) {
        a.ph_lo = ph; a.ph_hi = ph + 1;
        hipLaunchKernelGGL(fwd_kernel, dim3(grid), dim3(NWAVES * 64), LDS_BYTES, stream, a);
        const hipError_t le = hipPeekAtLastError();
        if (le != hipSuccess) { fprintf(stderr, "kernel_launch: launch %d failed: %s\n", ph, hipGetErrorName(le)); break; }
    }
#endif
}
```

```cpp
#include <hip/hip_runtime.h>
#include <hip/hip_cooperative_groups.h>
#include <cstdio>
#include <cstdint>
namespace cg = cooperative_groups;

namespace pg8 {
#define PG8_LAS __attribute__((address_space(3)))
typedef unsigned short bf16_t;
typedef short bf16x8 __attribute__((ext_vector_type(8)));
typedef float f32x4 __attribute__((ext_vector_type(4)));
typedef float f32x2 __attribute__((ext_vector_type(2)));
typedef unsigned u32x4 __attribute__((ext_vector_type(4)));
typedef _Float16 h16x2 __attribute__((ext_vector_type(2)));
constexpr int BM = 256, BK = 64, HALF = 128, HTB = HALF * BK * 2  , STAGE_BYTES = 8 * HTB, NXCD = 8, WGM = 8;

__host__ __device__ __forceinline__ int lds_byte(int r, int c) { const int st = (r >> 4) * 2 + (c >> 5), rr = r & 15, cc = c & 31, ob = rr * 64 + cc * 2; return st * 1024 + (ob ^ (((ob >> 9) & 1) << 5)); }
__host__ __device__ __forceinline__ void stage_rc(int b, int& R, int& C) { const int st = b / 1024, sb = b % 1024, swz = sb ^ (((sb >> 9) & 1) << 5); R = (st >> 1) * 16 + swz / 64; C = (st & 1) * 32 + (swz % 64) / 2; }
__host__ __device__ __forceinline__ int perm32(int rho) { const int n = rho >> 4, i = rho & 15; return 8 * (i >> 2) + 4 * n + (i & 3); }

struct Unit { int pm, pn; };
struct Gemm { const bf16_t* A; const bf16_t* Bt; int M, N, K; };

struct StaticOrder {
    int nM, nN, nwg, G, c;
    __host__ __device__ void init(int M, int N, int G_, int c_) { nM = M / BM; nN = N / BM; nwg = nM * nN; G = G_; c = c_; }
    __host__ __device__ __forceinline__ bool next(int i, Unit& u) const {
        const long L = (long)i * G + c; if (L >= nwg) return false;
        int wgid = (int)L; { const int q = nwg / NXCD, r = nwg % NXCD, xcd = wgid % NXCD, off = wgid / NXCD; wgid = (xcd < r ? xcd * (q + 1) : r * (q + 1) + (xcd - r) * q) + off; }
        const int nig = WGM * nN, gid = wgid / nig, fm = gid * WGM, gsz = (nM - fm) < WGM ? (nM - fm) : WGM;
        u.pm = fm + ((wgid % nig) % gsz); u.pn = (wgid % nig) / gsz; return true;
    }
    __device__ __forceinline__ const char* pa(const Gemm& g, const Unit& u) const { return (const char*)g.A + (size_t)u.pm * ((size_t)BM * g.K * 2); }
    __device__ __forceinline__ const char* pb(const Gemm& g, const Unit& u) const { return (const char*)g.Bt + (size_t)u.pn * ((size_t)BM * g.K * 2); }
    __device__ __forceinline__ void a_ready(const Unit&) const {}
    __device__ __forceinline__ void done(const Unit&) const {}
};
struct OrderG3 {
    int pm, pn0, valid; const bf16_t *a_xn, *a_oa, *a_ob;
    __device__ __forceinline__ void init(int M, int N, int G_, int c_) { StaticOrder b; b.init(M, N, G_, c_); Unit t; t.pm = 0; t.pn = 0; valid = b.next(0, t) ? 1 : 0; pm = t.pm; pn0 = t.pn; }
    __device__ __forceinline__ bool next(int i, Unit& u) const { if (i >= 4 || !valid) return false; u.pm = pm; u.pn = 4 * i + pn0; return true; }
    __device__ __forceinline__ const char* pa(const Gemm& g, const Unit& u) const { const int s = u.pn >> 2; const long long d1 = (const char*)a_oa - (const char*)a_xn, d3 = (const char*)a_ob - (const char*)a_xn; const long long off = (long long)(s == 1) * d1 + (long long)(s == 3) * d3; return (const char*)a_xn + off + (size_t)u.pm * ((size_t)BM * g.K * 2); }
    __device__ __forceinline__ const char* pb(const Gemm& g, const Unit& u) const { return (const char*)g.Bt + (size_t)u.pn * ((size_t)BM * g.K * 2); }
    __device__ __forceinline__ void a_ready(const Unit&) const {}
    __device__ __forceinline__ void done(const Unit&) const {}
};

typedef __bf16 bf16x2_t __attribute__((ext_vector_type(2)));
__device__ __forceinline__ unsigned cvt_pk_bf16(float lo, float hi) { const f32x2 v = {lo, hi}; return __builtin_bit_cast(unsigned, __builtin_convertvector(v, bf16x2_t)); }
__device__ __forceinline__ unsigned cvt_pk_f16(float lo, float hi) { h16x2 v; v.x = (_Float16)lo; v.y = (_Float16)hi; return __builtin_bit_cast(unsigned, v); }
__device__ __forceinline__ float fsigmoid(float x) { return __builtin_amdgcn_rcpf(1.0f + __expf(-x)); }

struct EpiG1 {
    static constexpr bool PERM = true, AFTER_DRAIN = false;
    bf16_t *Q, *KF, *VI, *HG, *R, *K, *V, *LZ; const float* lbraw;
    template <int MODE> __device__ __forceinline__ void tile(const f32x4 (&acc)[2][2][4][2], bf16_t* base, int ldc, int row0, int col0) const {
        float oml[2][8];
        if (MODE == 1) {
#pragma unroll
            for (int bj = 0; bj < 2; ++bj)
#pragma unroll
                for (int e = 0; e < 8; ++e) { const int c = col0 + bj * HALF + e; oml[bj][e] = fsigmoid(lbraw[1024 + c] - lbraw[c]); }
        }
#pragma unroll
        for (int ai = 0; ai < 2; ++ai)
#pragma unroll
            for (int m = 0; m < 4; ++m) { bf16_t* rowp = base + (size_t)(row0 + ai * HALF + m * 16) * ldc + col0;
#pragma unroll
                for (int bj = 0; bj < 2; ++bj) { float v[8];
#pragma unroll
                    for (int e = 0; e < 4; ++e) { v[e] = acc[ai][bj][m][0][e]; v[4 + e] = acc[ai][bj][m][1][e]; }
                    u32x4 w;
                    if (MODE == 0) {
#pragma unroll
                        for (int e = 0; e < 8; ++e) v[e] = v[e] * fsigmoid(v[e]) * 0.08838834764831845f;
                    } else if (MODE == 1) {
#pragma unroll
                        for (int e = 0; e < 8; ++e) v[e] = oml[bj][e] * fsigmoid(-v[e]);
                    } else if (MODE == 3) {
#pragma unroll
                        for (int e = 0; e < 8; ++e) v[e] = v[e] * fsigmoid(v[e]);
                    }
                    if (MODE == 1) { w.x = cvt_pk_f16(v[0], v[1]); w.y = cvt_pk_f16(v[2], v[3]); w.z = cvt_pk_f16(v[4], v[5]); w.w = cvt_pk_f16(v[6], v[7]); }
                    else { w.x = cvt_pk_bf16(v[0], v[1]); w.y = cvt_pk_bf16(v[2], v[3]); w.z = cvt_pk_bf16(v[4], v[5]); w.w = cvt_pk_bf16(v[6], v[7]); }
                    *(u32x4*)(rowp + bj * HALF) = w; } }
    }
    __device__ __forceinline__ void operator()(const f32x4 (&acc)[2][2][4][2], const Unit& u, int wr, int wc, int fr, int fq) const {
        const int pn = u.pn, row0 = u.pm * BM + wr * 64 + fr, cw = wc * 32 + 8 * fq;
        if (pn < 4) tile<0>(acc, Q, 1024, row0, pn * 256 + cw);
        else if (pn < 8) tile<1>(acc, KF, 1024, row0, (pn - 4) * 256 + cw);
        else if (pn < 12) tile<2>(acc, VI, 1024, row0, (pn - 8) * 256 + cw);
        else if (pn < 16) tile<3>(acc, HG, 1024, row0, (pn - 12) * 256 + cw);
        else if (pn < 20) tile<2>(acc, R, 1024, row0, (pn - 16) * 256 + cw);
        else if (pn < 24) tile<2>(acc, K, 1024, row0, (pn - 20) * 256 + cw);
        else if (pn < 28) tile<2>(acc, V, 1024, row0, (pn - 24) * 256 + cw);
        else tile<2>(acc, LZ, 256, row0, cw);
    }
};

struct EpiG3 {
    static constexpr bool PERM = true, AFTER_DRAIN = false;
    f32x4* scr;
    bf16_t* O;
    __device__ __forceinline__ void operator()(const f32x4 (&acc)[2][2][4][2], const Unit& u, int wr, int wc, int fr, int fq) const {
        const int s = u.pn >> 2, pn0 = u.pn & 3, tid = threadIdx.x;
        f32x4* t0 = scr + tid * 32; f32x4* t1 = scr + 32 * 512 + tid * 32;
        if (s == 0 || s == 2) { f32x4* t = s ? t1 : t0;
#pragma unroll
            for (int ai = 0; ai < 2; ++ai)
#pragma unroll
                for (int bj = 0; bj < 2; ++bj)
#pragma unroll
                    for (int m = 0; m < 4; ++m)
#pragma unroll
                        for (int n = 0; n < 2; ++n) { const f32x4 a = acc[ai][bj][m][n]; f32x4 r; r.x = fsigmoid(a.x); r.y = fsigmoid(a.y); r.z = fsigmoid(a.z); r.w = fsigmoid(a.w); t[((ai * 2 + bj) * 4 + m) * 2 + n] = r; }
        } else if (s == 1) {
#pragma unroll
            for (int ai = 0; ai < 2; ++ai)
#pragma unroll
                for (int bj = 0; bj < 2; ++bj)
#pragma unroll
                    for (int m = 0; m < 4; ++m)
                        { _Pragma("unroll") for (int n = 0; n < 2; ++n) { const int ix = ((ai * 2 + bj) * 4 + m) * 2 + n; t0[ix] = t0[ix] * acc[ai][bj][m][n]; } if (m & 1) asm volatile("" ::: "memory"); }
        } else {
            const int row0 = u.pm * BM + wr * 64 + fr, col0 = pn0 * BM + wc * 32 + 8 * fq;
#pragma unroll
            for (int ai = 0; ai < 2; ++ai)
#pragma unroll
                for (int m = 0; m < 4; ++m) { bf16_t* rowp = O + (size_t)(row0 + ai * HALF + m * 16) * 1024 + col0;
#pragma unroll
                    for (int bj = 0; bj < 2; ++bj) { const int ix = ((ai * 2 + bj) * 4 + m) * 2;
                        const f32x4 v0 = t0[ix] + t1[ix] * acc[ai][bj][m][0], v1 = t0[ix + 1] + t1[ix + 1] * acc[ai][bj][m][1];
                        u32x4 w; w.x = cvt_pk_bf16(v0[0], v0[1]); w.y = cvt_pk_bf16(v0[2], v0[3]); w.z = cvt_pk_bf16(v1[0], v1[1]); w.w = cvt_pk_bf16(v1[2], v1[3]);
                        *(u32x4*)(rowp + bj * HALF) = w; } asm volatile("" ::: "memory"); }
        }
    }
};

struct EpiF32SS {
    static constexpr bool PERM = false, AFTER_DRAIN = false;
    float* out; float* ssp; int ldc;
    __device__ __forceinline__ void operator()(const f32x4 (&acc)[2][2][4][2], const Unit& u, int wr, int wc, int fr, int fq) const {
        const int row0 = u.pm * BM + wr * 64 + fr, col0 = u.pn * BM + wc * 32 + 4 * fq;
#pragma unroll
        for (int ai = 0; ai < 2; ++ai)
#pragma unroll
            for (int m = 0; m < 4; ++m) { const int r = row0 + ai * HALF + m * 16; float s = 0.f;
#pragma unroll
                for (int bj = 0; bj < 2; ++bj)
#pragma unroll
                    for (int n = 0; n < 2; ++n) { const f32x4 x = acc[ai][bj][m][n]; s += (x[0] * x[0] + x[1] * x[1]) + (x[2] * x[2] + x[3] * x[3]); *(f32x4*)(out + (size_t)r * ldc + col0 + bj * HALF + n * 16) = x; }
                s += __shfl_xor(s, 16); s += __shfl_xor(s, 32);
                if (fq == 0) ssp[(size_t)r * 16 + u.pn * 4 + wc] = s; }
    }
};

struct EpiBf16Raw {
    static constexpr bool PERM = true, AFTER_DRAIN = false;
    bf16_t* O; int ldc;
    __device__ __forceinline__ void operator()(const f32x4 (&acc)[2][2][4][2], const Unit& u, int wr, int wc, int fr, int fq) const {
        const int row0 = u.pm * BM + wr * 64 + fr, col0 = u.pn * BM + wc * 32 + 8 * fq;
#pragma unroll
        for (int ai = 0; ai < 2; ++ai)
#pragma unroll
            for (int m = 0; m < 4; ++m) { bf16_t* rowp = O + (size_t)(row0 + ai * HALF + m * 16) * ldc + col0;
#pragma unroll
                for (int bj = 0; bj < 2; ++bj) { const f32x4 v0 = acc[ai][bj][m][0], v1 = acc[ai][bj][m][1];
                    u32x4 w; w.x = cvt_pk_bf16(v0[0], v0[1]); w.y = cvt_pk_bf16(v0[2], v0[3]); w.z = cvt_pk_bf16(v1[0], v1[1]); w.w = cvt_pk_bf16(v1[2], v1[3]);
                    *(u32x4*)(rowp + bj * HALF) = w; } }
    }
};

template <class Epi, class Sched, bool ALIGN_EPI = false, bool SP2 = false>
__device__ __forceinline__ void gemm_phase(PG8_LAS unsigned char* lds, const Gemm g, const Sched& S, const Epi& E) {
    const int tid = threadIdx.x, wid = __builtin_amdgcn_readfirstlane(tid >> 6), lane = tid & 63, wr = wid >> 2, wc = wid & 3, fr = lane & 15, fq = lane >> 4;
    const int K = g.K, nt = K / BK;
    unsigned voffA[2], voffB[2];
#pragma unroll
    for (int i = 0; i < 2; ++i) { int R, C; stage_rc(tid * 16 + i * 8192, R, C); const int Rb = Epi::PERM ? ((R & ~31) + perm32(R & 31)) : R;
        voffA[i] = (unsigned)(R * K + C) * 2u; voffB[i] = (unsigned)(Rb * K + C) * 2u; }
    const size_t kstep = (size_t)(BK * 2);
    const size_t hstep = (size_t)HALF * K * 2;
    const size_t tstep = 2 * hstep;
    const unsigned ldsw = (unsigned)wid * 1024u;
    const int aoff = lds_byte(wr * 64 + fr, fq * 8), boff = lds_byte(wc * 32 + fr, fq * 8);
#define PG8_SA(b, h) (((b) * 2 + (h)) * HTB)
#define PG8_SB(b, h) ((4 + (b) * 2 + (h)) * HTB)
#define PG8_STAGE(bufoff, gbase, voff) do { _Pragma("unroll") for (int _i = 0; _i < 2; ++_i) \
        __builtin_amdgcn_global_load_lds((const unsigned*)((const char*)(gbase) + (voff)[_i]), (PG8_LAS unsigned*)(lds + (bufoff) + ldsw + _i * 8192), 16, 0, 0); } while (0)
#define PG8_LDA(dst, b, h) do { _Pragma("unroll") for (int m = 0; m < 4; ++m) _Pragma("unroll") for (int k = 0; k < 2; ++k) dst[m][k] = *(const PG8_LAS bf16x8*)(lds + PG8_SA(b, h) + aoff + m * 2048 + k * 1024); } while (0)
#define PG8_LDB(dst, b, h) do { _Pragma("unroll") for (int n = 0; n < 2; ++n) _Pragma("unroll") for (int k = 0; k < 2; ++k) dst[n][k] = *(const PG8_LAS bf16x8*)(lds + PG8_SB(b, h) + boff + n * 2048 + k * 1024); } while (0)
#define PG8_MMA(ai, bj, At, Bt) do { __builtin_amdgcn_s_setprio(1); _Pragma("unroll") for (int m = 0; m < 4; ++m) _Pragma("unroll") for (int n = 0; n < 2; ++n) _Pragma("unroll") for (int k = 0; k < 2; ++k) \
        acc[ai][bj][m][n] = __builtin_amdgcn_mfma_f32_16x16x32_bf16(Bt[n][k], At[m][k], acc[ai][bj][m][n], 0, 0, 0); __builtin_amdgcn_s_setprio(0); } while (0)
#define PG8_WAIT_V(n) asm volatile("s_waitcnt vmcnt(" #n ")" ::: "memory")
#define PG8_WAIT_L(n) asm volatile("s_waitcnt lgkmcnt(" #n ")" ::: "memory")
#define PG8_BAR __builtin_amdgcn_s_barrier()
#define PG8_SCHED __builtin_amdgcn_sched_barrier(0)
    Unit cur, nxt; int ui = 0;
    if (!S.next(0, cur)) return;
    f32x4 acc[2][2][4][2];
#pragma unroll
    for (int a = 0; a < 2; ++a)
#pragma unroll
        for (int b = 0; b < 2; ++b)
#pragma unroll
            for (int m = 0; m < 4; ++m)
#pragma unroll
                for (int n = 0; n < 2; ++n) acc[a][b][m][n] = (f32x4){0.f, 0.f, 0.f, 0.f};
    bf16x8 At[4][2], B0[2][2], B1[2][2];
    const char* cA = S.pa(g, cur); const char* cB = S.pb(g, cur);
    S.a_ready(cur);
    if constexpr (SP2) {
        PG8_STAGE(PG8_SB(0, 0), cB, voffB); PG8_STAGE(PG8_SB(0, 1), cB + hstep, voffB); PG8_STAGE(PG8_SA(0, 0), cA, voffA); PG8_STAGE(PG8_SA(0, 1), cA + hstep, voffA);
        if (wr == 1) PG8_BAR;
        PG8_WAIT_V(2); PG8_BAR;
        PG8_STAGE(PG8_SB(1, 0), cB + kstep, voffB); PG8_STAGE(PG8_SA(1, 0), cA + kstep, voffA); PG8_STAGE(PG8_SB(1, 1), cB + hstep + kstep, voffB);
        PG8_WAIT_V(6); PG8_BAR;
    } else {
        PG8_STAGE(PG8_SB(0, 0), cB, voffB); PG8_STAGE(PG8_SA(0, 0), cA, voffA); PG8_STAGE(PG8_SB(0, 1), cB + hstep, voffB); PG8_STAGE(PG8_SA(0, 1), cA + hstep, voffA);
        if (wr == 1) PG8_BAR;
        PG8_WAIT_V(4); PG8_BAR;
        PG8_STAGE(PG8_SB(1, 0), cB + kstep, voffB); PG8_STAGE(PG8_SA(1, 0), cA + kstep, voffA); PG8_STAGE(PG8_SB(1, 1), cB + hstep + kstep, voffB);
        PG8_WAIT_V(6); PG8_BAR;
    }
    for (;;) {
        const bool has_next = S.next(ui + 1, nxt);
        const char* nA = has_next ? S.pa(g, nxt) : cA; const char* nB = has_next ? S.pb(g, nxt) : cB;
        for (int t = 0; t < nt; t += 2) {
            const bool last = (t == nt - 2);
            const char* a1 = cA + (size_t)(t + 1) * kstep;
            const char* a2 = last ? nA : cA + (size_t)(t + 2) * kstep; const char* b2 = last ? nB : cB + (size_t)(t + 2) * kstep;
            const char* a3 = a2 + kstep; const char* b3 = b2 + kstep;
            if (last && has_next) S.a_ready(nxt);
            if constexpr (SP2) {
            PG8_LDB(B0, 0, 0); PG8_LDB(B1, 0, 1); PG8_SCHED; PG8_LDA(At, 0, 0); PG8_STAGE(PG8_SA(1, 1), a1 + hstep, voffA);
            PG8_WAIT_V(8); PG8_WAIT_L(0); PG8_BAR; PG8_MMA(0, 0, At, B0); PG8_MMA(0, 1, At, B1); PG8_BAR; PG8_SCHED;
            PG8_LDA(At, 0, 1); PG8_STAGE(PG8_SB(0, 0), b2, voffB); PG8_STAGE(PG8_SB(0, 1), b2 + hstep, voffB); PG8_STAGE(PG8_SA(0, 0), a2, voffA);
            PG8_WAIT_V(8); PG8_WAIT_L(0); PG8_BAR; PG8_MMA(1, 0, At, B0); PG8_MMA(1, 1, At, B1); PG8_BAR; PG8_SCHED;
            PG8_LDB(B0, 1, 0); PG8_LDB(B1, 1, 1); PG8_SCHED; PG8_LDA(At, 1, 0); PG8_STAGE(PG8_SA(0, 1), a2 + hstep, voffA);
            PG8_WAIT_V(8); PG8_WAIT_L(0); PG8_BAR; PG8_MMA(0, 0, At, B0); PG8_MMA(0, 1, At, B1); PG8_BAR; PG8_SCHED;
            PG8_LDA(At, 1, 1); PG8_STAGE(PG8_SB(1, 0), b3, voffB); PG8_STAGE(PG8_SB(1, 1), b3 + hstep, voffB); PG8_STAGE(PG8_SA(1, 0), a3, voffA);
            PG8_WAIT_V(8); PG8_WAIT_L(0); PG8_BAR; PG8_MMA(1, 0, At, B0); PG8_MMA(1, 1, At, B1); PG8_BAR; PG8_SCHED;
            } else {
            PG8_LDB(B0, 0, 0); PG8_SCHED; PG8_LDA(At, 0, 0); PG8_STAGE(PG8_SA(1, 1), a1 + hstep, voffA);
            PG8_WAIT_L(8); PG8_BAR; PG8_WAIT_L(0); PG8_MMA(0, 0, At, B0); PG8_BAR; PG8_SCHED;
            PG8_LDB(B1, 0, 1); PG8_STAGE(PG8_SB(0, 0), b2, voffB);
            PG8_BAR; PG8_WAIT_L(0); PG8_MMA(0, 1, At, B1); PG8_BAR;
            PG8_LDA(At, 0, 1); PG8_STAGE(PG8_SA(0, 0), a2, voffA);
            PG8_BAR; PG8_WAIT_L(0); PG8_MMA(1, 0, At, B0); PG8_BAR; PG8_SCHED;
            PG8_STAGE(PG8_SB(0, 1), b2 + hstep, voffB);
            PG8_WAIT_V(6); PG8_BAR; PG8_MMA(1, 1, At, B1); PG8_BAR;
            PG8_LDB(B0, 1, 0); PG8_SCHED; PG8_LDA(At, 1, 0); PG8_STAGE(PG8_SA(0, 1), a2 + hstep, voffA);
            PG8_WAIT_L(8); PG8_BAR; PG8_WAIT_L(0); PG8_MMA(0, 0, At, B0); PG8_BAR; PG8_SCHED;
            PG8_LDB(B1, 1, 1); PG8_STAGE(PG8_SB(1, 0), b3, voffB);
            PG8_BAR; PG8_WAIT_L(0); PG8_MMA(0, 1, At, B1); PG8_BAR;
            PG8_LDA(At, 1, 1); PG8_STAGE(PG8_SA(1, 0), a3, voffA);
            PG8_BAR; PG8_WAIT_L(0); PG8_MMA(1, 0, At, B0); PG8_BAR; PG8_SCHED;
            PG8_STAGE(PG8_SB(1, 1), b3 + hstep, voffB);
            PG8_WAIT_V(6); PG8_BAR; PG8_MMA(1, 1, At, B1); PG8_BAR;
            }
        }
        if constexpr (ALIGN_EPI) { if (wr == 0) PG8_BAR; }
        if constexpr (!Epi::AFTER_DRAIN) { E(acc, cur, wr, wc, fr, fq); S.done(cur); }
        if (!has_next) break;
#pragma unroll
        for (int a = 0; a < 2; ++a)
#pragma unroll
            for (int b = 0; b < 2; ++b)
#pragma unroll
                for (int m = 0; m < 4; ++m)
#pragma unroll
                    for (int n = 0; n < 2; ++n) acc[a][b][m][n] = (f32x4){0.f, 0.f, 0.f, 0.f};
        cur = nxt; cA = nA; cB = nB; ++ui;
        if constexpr (ALIGN_EPI) { if (wr == 1) PG8_BAR; }
    }
    PG8_WAIT_V(0);
    if constexpr (!ALIGN_EPI) { if (wr == 0) PG8_BAR; }
    PG8_BAR;
    if constexpr (Epi::AFTER_DRAIN) { E.fused(acc, cur, wr, wc, fr, fq, lds, wid, lane); S.done(cur); }
#undef PG8_SA
#undef PG8_SB
#undef PG8_STAGE
#undef PG8_LDA
#undef PG8_LDB
#undef PG8_MMA
#undef PG8_WAIT_V
#undef PG8_WAIT_L
#undef PG8_BAR
#undef PG8_SCHED
}
}

constexpr int NWAVES = 8;
#ifndef MK_ONE_LAUNCH
#define MK_ONE_LAUNCH 1
#endif
constexpr int N_PHASES = 12;

constexpr int BATCH = 8, SEQ = 2048, D = 1024, M = BATCH * SEQ;
constexpr int IN_COLS = 9472, N1 = 7424;
constexpr int DFF = 2816, NUP = 2 * DFF;
constexpr int MH = M / 2;
constexpr float EPS = 1e-6f, GN_EPS = 64e-5f;

constexpr size_t MiB = 1u << 20;
constexpr size_t WS_CTL = 0;
constexpr size_t WS_W1 = 1 * MiB, WS_W3 = 16 * MiB, WS_WOUT = 24 * MiB, WS_WUP = 26 * MiB, WS_WDN = 37 * MiB, WS_LORA = 43 * MiB;
constexpr size_t WS_Q = 44 * MiB, WS_KF = 76 * MiB, WS_HG = 108 * MiB, WS_R = 140 * MiB, WS_K = 172 * MiB, WS_LZ = 204 * MiB, WS_VI = 212 * MiB;
constexpr size_t WS_SS1 = 244 * MiB, WS_SS3 = 252 * MiB;
constexpr size_t WS_SCR = 76 * MiB;
constexpr size_t WS_MRG = WS_Q;
constexpr size_t WS_MIX = 76 * MiB;
constexpr size_t WS_HB = WS_Q;
constexpr size_t WS_HU = 76 * MiB;
constexpr size_t WS_ACT = 164 * MiB;
constexpr size_t WS_END = 256 * MiB;
constexpr size_t OUT_XN = 0, OUT_V = 32 * MiB;

constexpr int LDS_BYTES = 147456;

#define GAS __attribute__((address_space(1)))
#define LAS __attribute__((address_space(3)))
typedef unsigned short bf16;
typedef unsigned v4u __attribute__((ext_vector_type(4)));
typedef unsigned v2u __attribute__((ext_vector_type(2)));
typedef float f32x4 __attribute__((ext_vector_type(4)));
typedef float f32x2 __attribute__((ext_vector_type(2)));
typedef short bf16x8 __attribute__((ext_vector_type(8)));
#define LDS_WAIT() asm volatile("s_waitcnt lgkmcnt(0)" ::: "memory")
#define VM_WAIT() asm volatile("s_waitcnt vmcnt(0)" ::: "memory")
__device__ __forceinline__ unsigned f2bf(float f) { return (unsigned)__builtin_bit_cast(unsigned short, (__bf16)f); }
__device__ __forceinline__ unsigned pk2(float lo, float hi) { return pg8::cvt_pk_bf16(lo, hi); }
__device__ __forceinline__ float bf_lo(unsigned u) { return __builtin_bit_cast(float, u << 16); }
__device__ __forceinline__ float bf_hi(unsigned u) { return __builtin_bit_cast(float, u & 0xffff0000u); }
__device__ __forceinline__ float bf1(unsigned short u) { return __builtin_bit_cast(float, (unsigned)u << 16); }
__device__ __forceinline__ float h1(unsigned short u) { return (float)__builtin_bit_cast(_Float16, u); }
__device__ __forceinline__ float fsig(float x) { return __builtin_amdgcn_rcpf(1.0f + __expf(-x)); }
__device__ __forceinline__ float wave_sum(float v) {
#pragma unroll
    for (int o = 1; o < 64; o <<= 1) v += __shfl_xor(v, o);
    return v;
}
template <int CTRL> __device__ __forceinline__ float dpp_f(float x) { return __builtin_bit_cast(float, __builtin_amdgcn_mov_dpp(__builtin_bit_cast(int, x), CTRL, 0xf, 0xf, false)); }
__device__ __forceinline__ float red16(float x) {
    x += dpp_f<0x128>(x); x += dpp_f<0x124>(x); x += dpp_f<0x122>(x); x += dpp_f<0x121>(x); return x;
}

struct Frame {
    LAS unsigned char* lds;
    int tid, lane, wave, G, bid;
    const float* in[26]; float* out; unsigned char* ws;
};

__device__ __forceinline__ void p0_tr_item(const float* W, int ldw, int n0, int K, bf16* WT, int r0, int nblk, LAS float* scr, int item, int lane) {
    const int kb = item / nblk, nb = item % nblk, k0 = 64 * kb, nn = 32 * nb;
#pragma unroll 8
    for (int i = 0; i < 32; ++i) { const int kk = 2 * i + (lane >> 5); scr[kk * 33 + (lane & 31)] = W[(size_t)(k0 + kk) * ldw + n0 + nn + (lane & 31)]; }
    LDS_WAIT(); asm volatile("" ::: "memory");
    const int c = lane & 7;
#pragma unroll
    for (int j = 0; j < 4; ++j) { const int n = (lane >> 3) + 8 * j; const LAS float* s = scr + (8 * c) * 33 + n;
        v4u o; o.x = pk2(s[0 * 33], s[1 * 33]); o.y = pk2(s[2 * 33], s[3 * 33]); o.z = pk2(s[4 * 33], s[5 * 33]); o.w = pk2(s[6 * 33], s[7 * 33]);
        *(GAS v4u*)(WT + (size_t)(r0 + nn + n) * K + k0 + 8 * c) = o; }
    LDS_WAIT(); asm volatile("" ::: "memory");
}
__device__ __forceinline__ void rms_row_to_bf16(int lane, const float* xrow, const float* g, bf16* orow) {
    const GAS f32x4* xr = (const GAS f32x4*)xrow + lane; const GAS f32x4* gr = (const GAS f32x4*)g + lane;
    f32x4 v[4]; float s = 0.f;
#pragma unroll
    for (int j = 0; j < 4; ++j) { v[j] = xr[64 * j]; s += (v[j].x * v[j].x + v[j].y * v[j].y) + (v[j].z * v[j].z + v[j].w * v[j].w); }
    const float rstd = __builtin_amdgcn_rsqf(wave_sum(s) * (1.f / D) + EPS);
    GAS unsigned long long* o8 = (GAS unsigned long long*)orow + lane;
#pragma unroll
    for (int j = 0; j < 4; ++j) { const f32x4 gg = gr[64 * j]; o8[64 * j] = (unsigned long long)pk2(v[j].x * rstd * gg.x, v[j].y * rstd * gg.y) | ((unsigned long long)pk2(v[j].z * rstd * gg.z, v[j].w * rstd * gg.w) << 32); }
}
__device__ __forceinline__ void p0_prologue(Frame& F) {
    LAS float* scr = (LAS float*)(F.lds + F.wave * 16384);
    const int gw = F.bid * NWAVES + F.wave, NGW = F.G * NWAVES;
    const float* w_in = F.in[2];
    bf16* W1 = (bf16*)(F.ws + WS_W1); bf16* W3 = (bf16*)(F.ws + WS_W3); bf16* WO = (bf16*)(F.ws + WS_WOUT); bf16* WU = (bf16*)(F.ws + WS_WUP); bf16* WD = (bf16*)(F.ws + WS_WDN);
    bf16* L2 = (bf16*)(F.ws + WS_LORA);
    constexpr int I_A = 16 * (N1 / 32), I_G = 16 * 32, I_UP = 16 * (NUP / 32), I_DN = (DFF / 64) * 32, I_L64 = 32, I_L128 = 64;
    constexpr int NITEMS = I_A + 5 * I_G + I_UP + I_DN + 2 * I_L64 + I_L128;
    for (int it = gw; it < NITEMS; it += NGW) {
        int r = it;
        if (r < I_A) { p0_tr_item(w_in, IN_COLS, 0, D, W1, 0, N1 / 32, scr, r, F.lane); continue; } r -= I_A;
        if (r < I_G) { p0_tr_item(w_in, IN_COLS, N1, D, W3, 0, 32, scr, r, F.lane); continue; } r -= I_G;
        if (r < I_G) { p0_tr_item(F.in[5], D, 0, D, W3, 1024, 32, scr, r, F.lane); continue; } r -= I_G;
        if (r < I_G) { p0_tr_item(w_in, IN_COLS, N1 + 1024, D, W3, 2048, 32, scr, r, F.lane); continue; } r -= I_G;
        if (r < I_G) { p0_tr_item(F.in[17], D, 0, D, W3, 3072, 32, scr, r, F.lane); continue; } r -= I_G;
        if (r < I_G) { p0_tr_item(F.in[18], D, 0, D, WO, 0, 32, scr, r, F.lane); continue; } r -= I_G;
        if (r < I_UP) { p0_tr_item(F.in[21], NUP, 0, D, WU, 0, NUP / 32, scr, r, F.lane); continue; } r -= I_UP;
        if (r < I_DN) { p0_tr_item(F.in[24], D, 0, DFF, WD, 0, 32, scr, r, F.lane); continue; } r -= I_DN;
        if (r < I_L64) { p0_tr_item(F.in[8], D, 0, 64, L2, 0, 32, scr, r, F.lane); continue; } r -= I_L64;
        if (r < I_L64) { p0_tr_item(F.in[10], D, 0, 64, L2 + 65536, 0, 32, scr, r, F.lane); continue; } r -= I_L64;
        p0_tr_item(F.in[11], D, 0, 128, L2 + 131072, 0, 32, scr, r, F.lane);
    }
    bf16* XN = (bf16*)((unsigned char*)F.out + OUT_XN);
    for (int m = gw; m < M; m += NGW) rms_row_to_bf16(F.lane, F.in[0] + (size_t)m * D, F.in[1], XN + (size_t)m * D);
}

__device__ __forceinline__ unsigned pk2r(float lo, float hi) { return pg8::cvt_pk_bf16(lo, hi); }
__device__ __forceinline__ bf16x8 mk8(unsigned a, unsigned b, unsigned c, unsigned d) { v4u u = {a, b, c, d}; return __builtin_bit_cast(bf16x8, u); }
__device__ __forceinline__ bf16x8 op4(const pg8::f32x4 x) { return mk8(pk2r(x[0], x[1]), pk2r(x[2], x[3]), 0u, 0u); }
__device__ __forceinline__ bf16x8 op44(const pg8::f32x4 x, const pg8::f32x4 y) { return mk8(pk2r(x[0], x[1]), pk2r(x[2], x[3]), pk2r(y[0], y[1]), pk2r(y[2], y[3])); }
#define MFMA16(a, b, c) __builtin_amdgcn_mfma_f32_16x16x32_bf16((a), (b), (c), 0, 0, 0)
__device__ __forceinline__ void rwkv_phase(Frame& F, int bh, bool dry) {
    typedef pg8::f32x4 f4;
    const int b = bh >> 4, h = bh & 15, tid = F.tid, lane = F.lane, wv = F.wave, fr = lane & 15, fq = lane >> 4;
    LAS unsigned char* L = F.lds;
    constexpr int SLOT = 17664, O_AR = 0, O_BKY = 4608, O_BTK = 9216, O_VF = 13312, O_A2 = 15360, O_M2 = 16384, O_WC = 17408, O_MU = 8 * SLOT, O_CST = O_MU + 1024, O_CARRY = O_CST + 2560;
    const bf16* L2 = (const bf16*)(F.ws + WS_LORA);
    const size_t rowbase = (size_t)b * SEQ;
    const GAS char* bR = (const GAS char*)(F.ws + WS_R) + (rowbase * D + h * 64) * 2; const GAS char* bK = (const GAS char*)(F.ws + WS_K) + (rowbase * D + h * 64) * 2;
    const GAS char* bV = (const GAS char*)((unsigned char*)F.out + OUT_V) + (rowbase * D + h * 64) * 2; GAS char* bO = (GAS char*)((unsigned char*)F.out + OUT_V) + (rowbase * D + h * 64) * 2;
    const GAS char* bLZ = (const GAS char*)(F.ws + WS_LZ) + rowbase * 512;
    const GAS char* bW2 = (const GAS char*)L2 + (size_t)h * 64 * 128, *bA2 = (const GAS char*)L2 + 131072 + (size_t)h * 64 * 128, *bG2 = (const GAS char*)L2 + 262144 + (size_t)h * 64 * 256;
    const float* mu = F.in[6];
    if (tid < 256) ((LAS float*)(L + O_MU))[tid] = mu[3072 + tid];
    for (int u = tid; u < 640; u += 512) { const int c = u >> 6, col = h * 64 + (u & 63);
        const float val = c == 0 ? F.in[7][col] : c == 1 ? F.in[9][col] : c == 2 ? F.in[12][col] : c == 3 ? F.in[13][col] : c == 4 ? F.in[14][col] : c == 5 ? F.in[15][col] : c == 6 ? F.in[16][col] : c == 7 ? mu[col] : c == 8 ? mu[1024 + col] : mu[2048 + col];
        ((LAS float*)(L + O_CST))[u] = val; }
#define CST(c, nt) (((const LAS float*)(L + O_CST))[(c) * 64 + 16 * (nt) + fr])
    LAS unsigned char* myslot = L + wv * SLOT;
    f4 St[4];
#pragma unroll
    for (int t = 0; t < 4; ++t) St[t] = (f4){0.f, 0.f, 0.f, 0.f};
    v4u lzc[8], lzq;
#define RW_LOAD_LZ(T0) do { const int tt0 = (T0); const unsigned tpv = (unsigned)(tt0 > 0 ? tt0 - 1 : 0); const unsigned oc = (unsigned)(tt0 + fr) * 512u + fq * 16u; \
        _Pragma("unroll") for (int s = 0; s < 8; ++s) lzc[s] = *(const GAS v4u*)(bLZ + (oc + s * 64u)); \
        lzq = *(const GAS v4u*)(bLZ + (tpv * 512u + (lane & 31) * 16u)); } while (0)
#define RW_LOAD_RKV(T0) do { const int tt0 = (T0); const unsigned tpv = (unsigned)(tt0 > 0 ? tt0 - 1 : 0); \
        _Pragma("unroll") for (int jj = 0; jj < 2; ++jj) { const int q = lane + 64 * jj; const unsigned o = (unsigned)(tt0 + (q >> 3)) * 2048u + (q & 7) * 16u; \
            rkv[jj] = *(const GAS v4u*)(bR + o); rkv[2 + jj] = *(const GAS v4u*)(bK + o); rkv[4 + jj] = *(const GAS v4u*)(bV + o); } \
        { const GAS char* pb_ = lane < 8 ? bR : lane < 16 ? bK : bV; rkv[6] = *(const GAS v4u*)(pb_ + (tpv * 2048u + (lane & 7) * 16u)); } } while (0)
    RW_LOAD_LZ(16 * wv);
    unsigned ggp[4][2]; float bonus[4];
    __syncthreads();
    const int lane_o = lane;
    for (int rnd = 0; rnd < SEQ / 128; ++rnd) {
        const int t0 = rnd * 128 + 16 * wv;
        int oz_; asm volatile("v_mov_b32 %0, 0" : "=v"(oz_));
        const int lane = lane_o + oz_, fr = lane & 15, fq = lane >> 4;
        {   v4u rkv[7];
            RW_LOAD_RKV(t0);
            if (lane < 32) *(LAS v4u*)(myslot + 6800 + lane * 16) = (t0 == 0) ? (v4u){0u, 0u, 0u, 0u} : lzq;
            LDS_WAIT(); asm volatile("" ::: "memory");
            bf16x8 afr[8];
#pragma unroll
            for (int s = 0; s < 8; ++s) { const LAS f4* mp = (const LAS f4*)(L + O_MU + (32 * s + 8 * fq) * 4); const f4 m0 = mp[0], m1 = mp[1];
                float x[8]; const v4u cy = *(const LAS v4u*)(myslot + 6800 + (4 * s + fq) * 16); const unsigned cu[4] = {lzc[s].x, lzc[s].y, lzc[s].z, lzc[s].w}, cyu[4] = {cy.x, cy.y, cy.z, cy.w}; unsigned pu[4];
#pragma unroll
                for (int e = 0; e < 4; ++e) { const unsigned sh = (unsigned)__builtin_amdgcn_mov_dpp((int)cu[e], 0x111, 0xf, 0xf, true); pu[e] = fr == 0 ? cyu[e] : sh; }
#pragma unroll
                for (int e = 0; e < 4; ++e) { const float z0 = bf_lo(cu[e]), z1 = bf_hi(cu[e]), p0 = bf_lo(pu[e]), p1 = bf_hi(pu[e]); const float ma = e < 2 ? m0[2 * e] : m1[2 * e - 4], mb = e < 2 ? m0[2 * e + 1] : m1[2 * e - 3];
                    x[2 * e] = z0 + ma * (p0 - z0); x[2 * e + 1] = z1 + mb * (p1 - z1); }
                if (s < 2) {
#pragma unroll
                    for (int e = 0; e < 8; ++e) x[e] = 1.f - 2.f * __builtin_amdgcn_rcpf(__expf(2.f * x[e]) + 1.f);
                } else if (s >= 4) {
#pragma unroll
                    for (int e = 0; e < 8; ++e) x[e] = fsig(x[e]);
                }
                afr[s] = mk8(pk2r(x[0], x[1]), pk2r(x[2], x[3]), pk2r(x[4], x[5]), pk2r(x[6], x[7])); }
            __builtin_amdgcn_sched_barrier(0);
#pragma unroll
            for (int jj = 0; jj < 2; ++jj) { const int q = lane + 64 * jj;
#pragma unroll
                for (int x3 = 0; x3 < 3; ++x3) *(LAS v4u*)(myslot + (1 + (q >> 3)) * 400 + x3 * 128 + (q & 7) * 16) = rkv[2 * x3 + jj]; }
            { v4u pr = rkv[6];
              if (wv == 0 && rnd > 0 && lane >= 16 && lane < 24) pr = *(const LAS v4u*)(L + O_CARRY + ((rnd - 1) & 1) * 128 + (lane & 7) * 16);
              if (wv == 7 && lane >= 56) *(LAS v4u*)(L + O_CARRY + (rnd & 1) * 128 + (lane - 56) * 16) = rkv[5];
              if (lane < 24) *(LAS v4u*)(myslot + (lane >> 3) * 128 + (lane & 7) * 16) = (t0 == 0) ? (v4u){0u, 0u, 0u, 0u} : pr; }
            LDS_WAIT(); asm volatile("" ::: "memory");
            __builtin_amdgcn_sched_barrier(0);
            float wd[4][4], asg[4][4];
            bf16x8 bq[2][8];
#define RW_LDB(dst, NT) do { const unsigned o64 = (unsigned)(16 * (NT) + fr) * 128u + fq * 16u, o128 = (unsigned)(16 * (NT) + fr) * 256u + fq * 16u; \
                _Pragma("unroll") for (int s = 0; s < 2; ++s) { dst[s] = *(const GAS bf16x8*)(bW2 + (o64 + s * 64u)); dst[2 + s] = *(const GAS bf16x8*)(bA2 + (o64 + s * 64u)); } \
                _Pragma("unroll") for (int s = 0; s < 4; ++s) dst[4 + s] = *(const GAS bf16x8*)(bG2 + (o128 + s * 64u)); } while (0)
            RW_LDB(bq[0], 0);
#pragma unroll
            for (int nt = 0; nt < 4; ++nt) {
                if (nt < 3) RW_LDB(bq[(nt + 1) & 1], nt + 1);
                asm volatile("" ::: "memory");
                f4 cw = {0.f, 0.f, 0.f, 0.f}, ca = cw, cgt = cw;
#pragma unroll
                for (int s = 0; s < 2; ++s) { cw = MFMA16(afr[s], bq[nt & 1][s], cw); ca = MFMA16(afr[2 + s], bq[nt & 1][2 + s], ca); }
#pragma unroll
                for (int s = 0; s < 4; ++s) cgt = MFMA16(afr[4 + s], bq[nt & 1][4 + s], cgt);
#pragma unroll
                for (int j = 0; j < 4; ++j) { const float wp = CST(0, nt) + cw[j]; const float wl = fminf(wp, 0.f) - __logf(1.f + __expf(-fabsf(wp))) - 0.5f;
                    wd[nt][j] = __expf(-__expf(wl)); asg[nt][j] = fsig(CST(1, nt) + ca[j]); }
                ggp[nt][0] = pk2r(cgt[0], cgt[1]); ggp[nt][1] = pk2r(cgt[2], cgt[3]);
                __builtin_amdgcn_sched_barrier(0); }
#undef RW_LDB
            __builtin_amdgcn_sched_barrier(0);
            float rl[4][4], kx[4][4], vv[4][4];
            float n2[4] = {0.f, 0.f, 0.f, 0.f}, bo[4] = {0.f, 0.f, 0.f, 0.f};
#pragma unroll
            for (int nt = 0; nt < 4; ++nt)
#pragma unroll
                for (int j = 0; j < 4; ++j) { const LAS unsigned short* sg = (const LAS unsigned short*)myslot + (4 * fq + j) * 200 + 16 * nt + fr;
                    const float r1 = bf1(sg[200]), r0 = bf1(sg[0]), k1 = bf1(sg[200 + 64]), k0 = bf1(sg[64]), v1 = bf1(sg[200 + 128]), v0 = bf1(sg[128]);
                    const float r_ = r1 + CST(7, nt) * (r0 - r1), kx_ = k1 + CST(8, nt) * (k0 - k1), v_ = v1 + CST(9, nt) * (v0 - v1);
                    rl[nt][j] = r_; vv[nt][j] = v_; kx[nt][j] = kx_; const float kkv = kx_ * CST(2, nt); n2[j] += kkv * kkv;
                    bo[j] += r_ * kx_ * (1.f + (asg[nt][j] - 1.f) * CST(3, nt)) * CST(4, nt); if (j == 3) __builtin_amdgcn_sched_barrier(0); }
            float inv[4];
#pragma unroll
            for (int j = 0; j < 4; ++j) { inv[j] = 1.f / fmaxf(__builtin_sqrtf(red16(n2[j])), 1e-12f); bonus[j] = red16(bo[j]); }
            LDS_WAIT(); asm volatile("" ::: "memory");
            __builtin_amdgcn_sched_barrier(0);
            LAS unsigned short* AR = (LAS unsigned short*)(myslot + O_AR); LAS unsigned short* BK = (LAS unsigned short*)(myslot + O_BKY);
#pragma unroll
            for (int nt = 0; nt < 4; ++nt) { float pf[4]; pf[0] = wd[nt][0]; pf[1] = pf[0] * wd[nt][1]; pf[2] = pf[1] * wd[nt][2]; pf[3] = pf[2] * wd[nt][3];
                const float s0 = __shfl(pf[3], fr), s1 = __shfl(pf[3], fr + 16), s2 = __shfl(pf[3], fr + 32), s3 = __shfl(pf[3], fr + 48);
                const float offs = fq == 0 ? 1.f : fq == 1 ? s0 : fq == 2 ? s0 * s1 : s0 * s1 * s2, WC = (s0 * s1) * (s2 * s3);
                const float ckk = CST(2, nt), cka = CST(3, nt);
                float btv[4], ktv[4];
#pragma unroll
                for (int j = 0; j < 4; ++j) { const float W = offs * pf[j], Wm1 = j == 0 ? offs : offs * pf[j - 1], iW = __builtin_amdgcn_rcpf(W);
                    const float kkn = kx[nt][j] * ckk * inv[j], a_ = asg[nt][j], k2v = kx[nt][j] * (1.f + (a_ - 1.f) * cka);
                    const float ah = -kkn * Wm1, rh = rl[nt][j] * W, bhv = kkn * a_ * iW, khv = k2v * iW; btv[j] = bhv * WC; ktv[j] = khv * WC;
                    const int ix = (4 * fq + j) * 72 + 16 * nt + fr;
                    AR[ix] = (unsigned short)f2bf(ah); AR[16 * 72 + ix] = (unsigned short)f2bf(rh); BK[ix] = (unsigned short)f2bf(bhv); BK[16 * 72 + ix] = (unsigned short)f2bf(khv); }
                *(LAS v4u*)(myslot + O_BTK + (nt * 64 + lane) * 16) = (v4u){pk2r(btv[0], btv[1]), pk2r(btv[2], btv[3]), pk2r(ktv[0], ktv[1]), pk2r(ktv[2], ktv[3])};
                *(LAS v2u*)(myslot + O_VF + (nt * 64 + lane) * 8) = (v2u){pk2r(vv[nt][0], vv[nt][1]), pk2r(vv[nt][2], vv[nt][3])};
                if (fq == 0) ((LAS float*)(myslot + O_WC))[16 * nt + fr] = WC;
                __builtin_amdgcn_sched_barrier(0); }
            LDS_WAIT(); asm volatile("" ::: "memory");
            bf16x8 fa0[2], fa1[2], fb0[2], fb1[2];
#pragma unroll
            for (int s = 0; s < 2; ++s) { fa0[s] = *(const LAS bf16x8*)(myslot + O_AR + (fr * 72 + 32 * s + 8 * fq) * 2); fa1[s] = *(const LAS bf16x8*)(myslot + O_AR + ((16 + fr) * 72 + 32 * s + 8 * fq) * 2);
                fb0[s] = *(const LAS bf16x8*)(myslot + O_BKY + (fr * 72 + 32 * s + 8 * fq) * 2); fb1[s] = *(const LAS bf16x8*)(myslot + O_BKY + ((16 + fr) * 72 + 32 * s + 8 * fq) * 2); }
            const f4 z4 = {0.f, 0.f, 0.f, 0.f};
            f4 Lab = MFMA16(fa0[1], fb0[1], MFMA16(fa0[0], fb0[0], z4)), Lak = MFMA16(fa0[1], fb1[1], MFMA16(fa0[0], fb1[0], z4));
            f4 Lt = MFMA16(fb0[1], fa0[1], MFMA16(fb0[0], fa0[0], z4)), MrbT = MFMA16(fb0[1], fa1[1], MFMA16(fb0[0], fa1[0], z4)), MrkT = MFMA16(fb1[1], fa1[1], MFMA16(fb1[0], fa1[0], z4));
#pragma unroll
            for (int j = 0; j < 4; ++j) { const int ri = 4 * fq + j; Lab[j] = ri > fr ? Lab[j] : 0.f; Lak[j] = ri > fr ? Lak[j] : 0.f; Lt[j] = fr > ri ? Lt[j] : 0.f; MrbT[j] = fr >= ri ? MrbT[j] : 0.f; MrkT[j] = fr >= ri ? MrkT[j] : 0.f; }
            __builtin_amdgcn_sched_barrier(0);
            const bf16x8 oL = op4(Lab), oLt = op4(Lt);
            const f4 L2t = MFMA16(oLt, oL, z4), Lt2 = MFMA16(oL, oLt, z4);
            const bf16x8 oL2 = op4(L2t), oLt2 = op4(Lt2);
            const f4 L4t = MFMA16(oLt2, oL2, z4), Lt4 = MFMA16(oL2, oLt2, z4);
            const bf16x8 oL4 = op4(L4t);
            const f4 L8t = MFMA16(op4(Lt4), oL4, z4);
            f4 X = Lt;
#pragma unroll
            for (int j = 0; j < 4; ++j) X[j] += (4 * fq + j == fr) ? 1.f : 0.f;
            X = MFMA16(oL2, op4(X), X); X = MFMA16(oL4, op4(X), X); X = MFMA16(op4(L8t), op4(X), X);
            const f4 TLt = MFMA16(op4(Lak), op4(X), z4);
            *(LAS bf16x8*)(myslot + O_A2 + lane * 16) = op44(X, TLt);
            *(LAS bf16x8*)(myslot + O_M2 + lane * 16) = op44(MrbT, MrkT);
        }
        LDS_WAIT();
        __syncthreads();
        if (wv < 4) {
#pragma unroll 1
            for (int sl = 0; sl < 8; ++sl) { const LAS unsigned char* sb = L + sl * SLOT;
                const bf16x8 b1a = op44(St[0], St[1]), b1b = op44(St[2], St[3]);
                f4 Pt = {0.f, 0.f, 0.f, 0.f}, Pb = Pt;
#pragma unroll
                for (int s = 0; s < 2; ++s) { const v2u l0 = *(const LAS v2u*)(sb + O_AR + (fr * 72 + 32 * s + 4 * fq) * 2), h0 = *(const LAS v2u*)(sb + O_AR + (fr * 72 + 32 * s + 16 + 4 * fq) * 2);
                    const v2u l1 = *(const LAS v2u*)(sb + O_AR + ((16 + fr) * 72 + 32 * s + 4 * fq) * 2), h1 = *(const LAS v2u*)(sb + O_AR + ((16 + fr) * 72 + 32 * s + 16 + 4 * fq) * 2);
                    Pt = MFMA16(mk8(l0.x, l0.y, h0.x, h0.y), s ? b1b : b1a, Pt); Pb = MFMA16(mk8(l1.x, l1.y, h1.x, h1.y), s ? b1b : b1a, Pb); }
                const v2u vf = *(const LAS v2u*)(sb + O_VF + (wv * 64 + lane) * 8);
                const f4 U = MFMA16(*(const LAS bf16x8*)(sb + O_A2 + lane * 16), mk8(pk2r(Pt[0], Pt[1]), pk2r(Pt[2], Pt[3]), vf.x, vf.y), ((f4){0.f, 0.f, 0.f, 0.f}));
                const bf16x8 b3 = mk8(pk2r(U[0], U[1]), pk2r(U[2], U[3]), vf.x, vf.y);
                const f4 Yt = MFMA16(*(const LAS bf16x8*)(sb + O_M2 + lane * 16), b3, Pb);
#pragma unroll
                for (int t = 0; t < 4; ++t) { const f4 dec = *(const LAS f4*)(sb + O_WC + (16 * t + 4 * fq) * 4); St[t] = MFMA16(*(const LAS bf16x8*)(sb + O_BTK + (t * 64 + lane) * 16), b3, St[t] * dec); }
#pragma unroll
                for (int j = 0; j < 4; ++j) ((LAS float*)(sb + O_BKY))[(4 * fq + j) * 64 + 16 * wv + fr] = Yt[j];
            }
        }
        LDS_WAIT();
        __syncthreads();
        { const LAS float* Yl = (const LAS float*)(myslot + O_BKY) + (4 * fq) * 64 + fr; float mean[4], rs[4];
#pragma unroll
          for (int j = 0; j < 4; ++j) { const float s_ = (Yl[j * 64] + Yl[j * 64 + 16]) + (Yl[j * 64 + 32] + Yl[j * 64 + 48]); mean[j] = red16(s_) * (1.f / 64.f); }
#pragma unroll
          for (int j = 0; j < 4; ++j) { const float d0 = Yl[j * 64] - mean[j], d1 = Yl[j * 64 + 16] - mean[j], d2 = Yl[j * 64 + 32] - mean[j], d3 = Yl[j * 64 + 48] - mean[j];
              rs[j] = __builtin_amdgcn_rsqf(red16((d0 * d0 + d1 * d1) + (d2 * d2 + d3 * d3)) * (1.f / 64.f) + GN_EPS); }
          __builtin_amdgcn_sched_barrier(0);
#pragma unroll
          for (int nt = 0; nt < 4; ++nt) { const v2u vf = *(const LAS v2u*)(myslot + O_VF + (nt * 64 + lane) * 8); const float lw = CST(5, nt), lb = CST(6, nt);
              const float v4_[4] = {bf_lo(vf.x), bf_hi(vf.x), bf_lo(vf.y), bf_hi(vf.y)}, g4_[4] = {bf_lo(ggp[nt][0]), bf_hi(ggp[nt][0]), bf_lo(ggp[nt][1]), bf_hi(ggp[nt][1])};
#pragma unroll
              for (int j = 0; j < 4; ++j) { const float o = ((Yl[j * 64 + 16 * nt] - mean[j]) * rs[j] * lw + lb + bonus[j] * v4_[j]) * g4_[j];
                  if (!dry) *(GAS unsigned short*)(bO + ((unsigned)(t0 + 4 * fq + j) * 2048u + (16 * nt + fr) * 2u)) = (unsigned short)f2bf(o); }
              __builtin_amdgcn_sched_barrier(0); } }
        if (rnd + 1 < SEQ / 128) RW_LOAD_LZ(t0 + 128);
    }
#undef RW_LOAD_LZ
#undef RW_LOAD_RKV
#undef CST
}

__device__ __forceinline__ void hgrn_phase(Frame& F, int bh, bool dry) {
    const int b = bh >> 3, h = bh & 7, tid = F.tid, lane = F.lane, w = F.wave, fr = lane & 15, fq = lane >> 4;
    LAS unsigned char* L = F.lds;
    constexpr int QIN = 0, KIN = 8704, QDEC = 17408, KDT = 26112, VT = 36352, SCM = 46592, SB = 49152, OBUF = 83968, SEG = 100864, DEC = 102912;
    const bf16* Qg = (const bf16*)(F.ws + WS_Q); const bf16* KFg = (const bf16*)(F.ws + WS_KF); const bf16* HGg = (const bf16*)(F.ws + WS_HG); bf16* VIg = (bf16*)(F.ws + WS_VI);
    const float* gn = F.in[4];
    const int k = tid & 127, q = tid >> 7;
    const size_t rowbase = (size_t)b * SEQ; const int colb = h * 128;
    for (int u = tid; u < 34816 / 16; u += 512) *(LAS v4u*)(L + SB + u * 16) = (v4u){0u, 0u, 0u, 0u};
    pg8::f32x4 Sacc[8];
#pragma unroll
    for (int t = 0; t < 8; ++t) Sacc[t] = (pg8::f32x4){0.f, 0.f, 0.f, 0.f};
    unsigned short pq[8], pk[8], pv[8];
#define HGRN_PREFETCH(T0) do { _Pragma("unroll") for (int j = 0; j < 8; ++j) { const size_t off = (rowbase + (T0) + 8 * q + j) * D + colb + k; pq[j] = Qg[off]; pk[j] = KFg[off]; pv[j] = VIg[off]; } } while (0)
    HGRN_PREFETCH(0);
    const float g0 = gn[colb + lane], g1 = gn[colb + 64 + lane];
    __syncthreads();
    for (int c = 0; c < SEQ / 32; ++c) {
        const int t0 = 32 * c;
        float qf[8], kf[8], pl[8];
        { float run = 0.f;
#pragma unroll
          for (int j = 0; j < 8; ++j) { qf[j] = bf1(pq[j]); kf[j] = h1(pk[j]); run += __logf(1.f - kf[j]); pl[j] = run; }
          ((LAS float*)(L + SEG))[q * 128 + k] = run;
          v4u o; o.x = (unsigned)pv[0] | ((unsigned)pv[1] << 16); o.y = (unsigned)pv[2] | ((unsigned)pv[3] << 16); o.z = (unsigned)pv[4] | ((unsigned)pv[5] << 16); o.w = (unsigned)pv[6] | ((unsigned)pv[7] << 16);
          *(LAS v4u*)(L + VT + (k * 40 + 8 * q) * 2) = o; }
        __syncthreads();
        if (c + 1 < SEQ / 32) HGRN_PREFETCH(t0 + 32);
        { const LAS float* seg = (const LAS float*)(L + SEG);
          const float s0 = seg[k], s1 = seg[128 + k], s2 = seg[256 + k], s3 = seg[384 + k];
          const float offs = q == 0 ? 0.f : q == 1 ? s0 : q == 2 ? s0 + s1 : s0 + s1 + s2;
          const float bref = s0 + s1, blast = (s0 + s1) + (s2 + s3);
          const float Elr = __expf(blast - bref), Eref = __expf(bref);
          if (q == 3) ((LAS float*)(L + DEC))[k] = Elr * Eref;
          unsigned short kd[8];
#pragma unroll
          for (int j = 0; j < 8; ++j) { const float bj = offs + pl[j]; const float e1 = __expf(bj - bref), r1 = __builtin_amdgcn_rcpf(e1); const int i = 8 * q + j;
              *(LAS unsigned short*)(L + QIN + (i * 136 + k) * 2) = (unsigned short)f2bf(qf[j] * e1);
              *(LAS unsigned short*)(L + KIN + (i * 136 + k) * 2) = (unsigned short)f2bf(kf[j] * r1);
              *(LAS unsigned short*)(L + QDEC + (i * 136 + k) * 2) = (unsigned short)f2bf(qf[j] * e1 * Eref);
              kd[j] = (unsigned short)f2bf(kf[j] * Elr * r1); }
          v4u o; o.x = (unsigned)kd[0] | ((unsigned)kd[1] << 16); o.y = (unsigned)kd[2] | ((unsigned)kd[3] << 16); o.z = (unsigned)kd[4] | ((unsigned)kd[5] << 16); o.w = (unsigned)kd[6] | ((unsigned)kd[7] << 16);
          *(LAS v4u*)(L + KDT + (k * 40 + 8 * q) * 2) = o; }
        __syncthreads();
        pg8::f32x4 oacc[2];
#pragma unroll
        for (int t = 0; t < 2; ++t) { const int tile = 2 * w + t, ti = tile >> 3, tv = tile & 7; pg8::f32x4 a = {0.f, 0.f, 0.f, 0.f};
#pragma unroll
            for (int ks = 0; ks < 4; ++ks) { const bf16x8 af = *(const LAS bf16x8*)(L + QDEC + ((16 * ti + fr) * 136 + ks * 32 + 8 * fq) * 2); const bf16x8 bfm = *(const LAS bf16x8*)(L + SB + ((16 * tv + fr) * 136 + ks * 32 + 8 * fq) * 2);
                a = __builtin_amdgcn_mfma_f32_16x16x32_bf16(af, bfm, a, 0, 0, 0); }
            oacc[t] = a; }
        if (w < 4) { const int ti = w >> 1, tj = w & 1; pg8::f32x4 a = {0.f, 0.f, 0.f, 0.f};
            if (tj <= ti) {
#pragma unroll
                for (int ks = 0; ks < 4; ++ks) { const bf16x8 af = *(const LAS bf16x8*)(L + QIN + ((16 * ti + fr) * 136 + ks * 32 + 8 * fq) * 2); const bf16x8 bfm = *(const LAS bf16x8*)(L + KIN + ((16 * tj + fr) * 136 + ks * 32 + 8 * fq) * 2);
                    a = __builtin_amdgcn_mfma_f32_16x16x32_bf16(af, bfm, a, 0, 0, 0); } }
#pragma unroll
            for (int j = 0; j < 4; ++j) { const int i = 16 * ti + 4 * fq + j, jj = 16 * tj + fr; const float s = (jj <= i) ? a[j] : 0.f; *(LAS unsigned short*)(L + SCM + (i * 40 + jj) * 2) = (unsigned short)f2bf(s); } }
        __syncthreads();
        { bf16x8 vfr[8];
#pragma unroll
          for (int tv = 0; tv < 8; ++tv) vfr[tv] = *(const LAS bf16x8*)(L + VT + ((16 * tv + fr) * 40 + 8 * fq) * 2);
#pragma unroll
          for (int t = 0; t < 2; ++t) { const int tile = 2 * w + t, ti = tile >> 3, tv = tile & 7;
              const bf16x8 af = *(const LAS bf16x8*)(L + SCM + ((16 * ti + fr) * 40 + 8 * fq) * 2);
              const bf16x8 bfm = *(const LAS bf16x8*)(L + VT + ((16 * tv + fr) * 40 + 8 * fq) * 2);
              oacc[t] = __builtin_amdgcn_mfma_f32_16x16x32_bf16(af, bfm, oacc[t], 0, 0, 0);
#pragma unroll
              for (int j = 0; j < 4; ++j) ((LAS float*)(L + OBUF))[(16 * ti + 4 * fq + j) * 132 + 16 * tv + fr] = oacc[t][j]; }
          const pg8::f32x4 d4 = *(const LAS pg8::f32x4*)(L + DEC + (16 * w + 4 * fq) * 4);
          const bf16x8 kfrag = *(const LAS bf16x8*)(L + KDT + ((16 * w + fr) * 40 + 8 * fq) * 2);
#pragma unroll
          for (int tv = 0; tv < 8; ++tv) { pg8::f32x4 s = Sacc[tv] * d4; s = __builtin_amdgcn_mfma_f32_16x16x32_bf16(kfrag, vfr[tv], s, 0, 0, 0); Sacc[tv] = s;
              v2u o; o.x = pk2(s[0], s[1]); o.y = pk2(s[2], s[3]); *(LAS v2u*)(L + SB + ((16 * tv + fr) * 136 + 16 * w + 4 * fq) * 2) = o; } }
        __syncthreads();
        { const LAS float* ob = (const LAS float*)(L + OBUF);
#pragma unroll
          for (int jj = 0; jj < 4; ++jj) { const int i = 4 * w + jj; const float o0 = ob[i * 132 + lane], o1 = ob[i * 132 + 64 + lane];
              const float rstd = __builtin_amdgcn_rsqf(wave_sum(o0 * o0 + o1 * o1) * (1.f / 128.f) + EPS);
              const size_t off = (rowbase + t0 + i) * D + colb + lane;
              if (!dry) { VIg[off] = (bf16)f2bf(o0 * rstd * g0 * bf1(HGg[off])); VIg[off + 64] = (bf16)f2bf(o1 * rstd * g1 * bf1(HGg[off + 64])); } } }
    }
}

__device__ __forceinline__ void p5_rows(Frame& F) {
    const int gw = F.bid * NWAVES + F.wave, NGW = F.G * NWAVES, lane = F.lane;
    const float* MIX = (const float*)(F.ws + WS_MIX); const float* SSP = (const float*)(F.ws + WS_SS1); bf16* HB = (bf16*)(F.ws + WS_HB);
    const GAS f32x4* g1 = (const GAS f32x4*)F.in[19] + lane; const GAS f32x4* g2 = (const GAS f32x4*)F.in[20] + lane;
    for (int m = gw; m < M; m += NGW) {
        const float sp = lane < 16 ? SSP[(size_t)m * 16 + lane] : 0.f;
        const float rstd1 = __builtin_amdgcn_rsqf(wave_sum(sp) * (1.f / D) + EPS);
        const GAS f32x4* mr = (const GAS f32x4*)(MIX + (size_t)m * D) + lane; const GAS f32x4* xr = (const GAS f32x4*)(F.in[0] + (size_t)m * D) + lane; GAS f32x4* hr = (GAS f32x4*)(F.out + (size_t)m * D) + lane;
        f32x4 hv[4]; float s = 0.f;
#pragma unroll
        for (int j = 0; j < 4; ++j) { hv[j] = xr[64 * j] + mr[64 * j] * rstd1 * g1[64 * j]; hr[64 * j] = hv[j]; s += (hv[j].x * hv[j].x + hv[j].y * hv[j].y) + (hv[j].z * hv[j].z + hv[j].w * hv[j].w); }
        const float rstd2 = __builtin_amdgcn_rsqf(wave_sum(s) * (1.f / D) + EPS);
        GAS unsigned long long* o8 = (GAS unsigned long long*)(HB + (size_t)m * D) + lane;
#pragma unroll
        for (int j = 0; j < 4; ++j) { const f32x4 gg = g2[64 * j]; o8[64 * j] = (unsigned long long)pk2(hv[j].x * rstd2 * gg.x, hv[j].y * rstd2 * gg.y) | ((unsigned long long)pk2(hv[j].z * rstd2 * gg.z, hv[j].w * rstd2 * gg.w) << 32); }
    }
}
__device__ __forceinline__ void p11_rows(Frame& F) {
    const int gw = F.bid * NWAVES + F.wave, NGW = F.G * NWAVES, lane = F.lane;
    const float* FFo = (const float*)(F.ws + WS_MIX); const float* SSP = (const float*)(F.ws + WS_SS3);
    const GAS f32x4* g3 = (const GAS f32x4*)F.in[25] + lane;
    for (int m = gw; m < M; m += NGW) {
        const float sp = lane < 16 ? SSP[(size_t)m * 16 + lane] : 0.f;
        const float rstd = __builtin_amdgcn_rsqf(wave_sum(sp) * (1.f / D) + EPS);
        const GAS f32x4* fr = (const GAS f32x4*)(FFo + (size_t)m * D) + lane; GAS f32x4* hr = (GAS f32x4*)(F.out + (size_t)m * D) + lane;
#pragma unroll
        for (int j = 0; j < 4; ++j) hr[64 * j] = hr[64 * j] + fr[64 * j] * rstd * g3[64 * j];
    }
}
__device__ __forceinline__ void conv_phase(Frame& F, int half) {
    const bf16* HU = (const bf16*)(F.ws + WS_HU); bf16* ACT = (bf16*)(F.ws + WS_ACT);
    const float* cw = F.in[22]; const float* cb = F.in[23];
    constexpr int NCG = DFF / 8, NRR = MH / 32, NT = NCG * NRR;
    for (int task = F.bid * 512 + F.tid; task < NT; task += F.G * 512) {
        const int cgi = task % NCG, rr = task / NCG, c = 8 * cgi, r0 = 32 * rr;
        float wg[3][8], wv[3][8], bg[8], bv[8];
#pragma unroll
        for (int e = 0; e < 8; ++e) { bg[e] = cb[c + e]; bv[e] = cb[DFF + c + e];
#pragma unroll
            for (int j = 0; j < 3; ++j) { wg[j][e] = cw[j * NUP + c + e]; wv[j][e] = cw[j * NUP + DFF + c + e]; } }
        float g1[8], g2[8], v1[8], v2[8];
        const bool seq_start = (r0 % SEQ) == 0;
        auto unpack = [](v4u u, float* o) { o[0] = bf_lo(u.x); o[1] = bf_hi(u.x); o[2] = bf_lo(u.y); o[3] = bf_hi(u.y); o[4] = bf_lo(u.z); o[5] = bf_hi(u.z); o[6] = bf_lo(u.w); o[7] = bf_hi(u.w); };
        if (seq_start) {
#pragma unroll
            for (int e = 0; e < 8; ++e) { g1[e] = g2[e] = v1[e] = v2[e] = 0.f; }
        } else { unpack(*(const GAS v4u*)(HU + (size_t)(r0 - 1) * NUP + c), g1); unpack(*(const GAS v4u*)(HU + (size_t)(r0 - 2) * NUP + c), g2);
                 unpack(*(const GAS v4u*)(HU + (size_t)(r0 - 1) * NUP + DFF + c), v1); unpack(*(const GAS v4u*)(HU + (size_t)(r0 - 2) * NUP + DFF + c), v2); }
#pragma unroll 4
        for (int i = 0; i < 32; ++i) { float g0[8], v0[8]; unpack(*(const GAS v4u*)(HU + (size_t)(r0 + i) * NUP + c), g0); unpack(*(const GAS v4u*)(HU + (size_t)(r0 + i) * NUP + DFF + c), v0);
            float o[8];
#pragma unroll
            for (int e = 0; e < 8; ++e) { const float gt = bg[e] + wg[0][e] * g2[e] + wg[1][e] * g1[e] + wg[2][e] * g0[e]; const float vl = bv[e] + wv[0][e] * v2[e] + wv[1][e] * v1[e] + wv[2][e] * v0[e];
                o[e] = gt * fsig(gt) * vl; g2[e] = g1[e]; g1[e] = g0[e]; v2[e] = v1[e]; v1[e] = v0[e]; }
            v4u w; w.x = pk2(o[0], o[1]); w.y = pk2(o[2], o[3]); w.z = pk2(o[4], o[5]); w.w = pk2(o[6], o[7]);
            *(GAS v4u*)(ACT + (size_t)(half * MH + r0 + i) * DFF + c) = w; }
    }
}

struct Args { const float* in[26]; float* out; unsigned char* ws; int ph_lo, ph_hi; };
__global__ void __launch_bounds__(NWAVES * 64, 2) fwd_kernel(Args args) {
    extern __shared__ __attribute__((aligned(16))) unsigned char lds[];
    Frame F;
    F.lds = (LAS unsigned char*)lds; F.tid = threadIdx.x; F.lane = F.tid & 63; F.wave = __builtin_amdgcn_readfirstlane(F.tid >> 6); F.G = gridDim.x; F.bid = blockIdx.x;
#pragma unroll
    for (int i = 0; i < 26; ++i) F.in[i] = args.in[i];
    F.out = args.out; F.ws = args.ws;
    const int lo = args.ph_lo, hi = args.ph_hi;
#ifndef REP_MASK
#define REP_MASK 0
#endif
#define NREP(k) (1 + ((REP_MASK >> (k)) & 1))
#ifndef DIAG_SCAN
#define DIAG_SCAN 3
#endif
#ifndef DIAG_MASK
#define DIAG_MASK 0xFFF
#endif
#define IN(k) (((DIAG_MASK >> (k)) & 1) && lo <= (k) && (k) < hi)
#define SEAM(k) do { if (IN(k) && IN((k) + 1)) { cg::this_grid().sync(); } } while (0)
    unsigned char* ws = args.ws; unsigned char* ob = (unsigned char*)args.out;
    if (IN(0)) { _Pragma("unroll 1") for (int rep = 0; rep < NREP(0); ++rep) p0_prologue(F); } SEAM(0);
    if (IN(1)) {
        pg8::Gemm g{(const pg8::bf16_t*)(ob + OUT_XN), (const pg8::bf16_t*)(ws + WS_W1), M, N1, D}; pg8::StaticOrder S; S.init(M, N1, F.G, F.bid);
        pg8::EpiG1 E{(bf16*)(ws + WS_Q), (bf16*)(ws + WS_KF), (bf16*)(ws + WS_VI), (bf16*)(ws + WS_HG), (bf16*)(ws + WS_R), (bf16*)(ws + WS_K), (bf16*)(ob + OUT_V), (bf16*)(ws + WS_LZ), F.in[3]};
        _Pragma("unroll 1") for (int rep = 0; rep < NREP(1); ++rep) { pg8::gemm_phase<pg8::EpiG1, pg8::StaticOrder, true, true>(F.lds, g, S, E); __syncthreads(); }
    } SEAM(1);
    if (IN(2)) {
        if (F.bid < 128) { _Pragma("unroll 1") for (int rep = 0; rep < NREP(2); ++rep) { rwkv_phase(F, F.bid, rep + 1 < NREP(2)); __syncthreads(); } } else if (F.bid < 192) { _Pragma("unroll 1") for (int rep = 0; rep < NREP(12); ++rep) { hgrn_phase(F, F.bid - 128, rep + 1 < NREP(12)); __syncthreads(); } }
    } SEAM(2);
    if (IN(3)) {
        pg8::Gemm g{(const pg8::bf16_t*)(ob + OUT_XN), (const pg8::bf16_t*)(ws + WS_W3), M, 4096, D};
        pg8::OrderG3 S; S.init(M, D, F.G, F.bid); S.a_xn = (const pg8::bf16_t*)(ob + OUT_XN); S.a_oa = (const pg8::bf16_t*)(ws + WS_VI); S.a_ob = (const pg8::bf16_t*)(ob + OUT_V);
        pg8::EpiG3 E{(pg8::f32x4*)(ws + WS_SCR) + (size_t)F.bid * (2 * 32 * 512), (bf16*)(ws + WS_MRG)};
        _Pragma("unroll 1") for (int rep = 0; rep < NREP(3); ++rep) { pg8::gemm_phase<pg8::EpiG3, pg8::OrderG3, false, true>(F.lds, g, S, E); __syncthreads(); }
    } SEAM(3);
    if (IN(4)) {
        pg8::Gemm g{(const pg8::bf16_t*)(ws + WS_MRG), (const pg8::bf16_t*)(ws + WS_WOUT), M, D, D}; pg8::StaticOrder S; S.init(M, D, F.G, F.bid);
        pg8::EpiF32SS E{(float*)(ws + WS_MIX), (float*)(ws + WS_SS1), D};
        _Pragma("unroll 1") for (int rep = 0; rep < NREP(4); ++rep) { pg8::gemm_phase<pg8::EpiF32SS, pg8::StaticOrder, false, true>(F.lds, g, S, E); __syncthreads(); }
    } SEAM(4);
    if (IN(5)) { _Pragma("unroll 1") for (int rep = 0; rep < NREP(5); ++rep) p5_rows(F); } SEAM(5);
#pragma unroll 1
    for (int half = 0; half < 2; ++half) {
        if (IN(6 + 2 * half)) {
            pg8::Gemm g{(const pg8::bf16_t*)(ws + WS_HB) + (size_t)half * MH * D, (const pg8::bf16_t*)(ws + WS_WUP), MH, NUP, D}; pg8::StaticOrder S; S.init(MH, NUP, F.G, F.bid);
            pg8::EpiBf16Raw E{(bf16*)(ws + WS_HU), NUP};
            _Pragma("unroll 1") for (int rep = 0; rep < NREP(6); ++rep) { pg8::gemm_phase<pg8::EpiBf16Raw, pg8::StaticOrder, true, true>(F.lds, g, S, E); __syncthreads(); }
        } SEAM(6 + 2 * half);
        if (IN(7 + 2 * half)) { _Pragma("unroll 1") for (int rep = 0; rep < NREP(7); ++rep) conv_phase(F, half); } SEAM(7 + 2 * half);
    }
    if (IN(10)) {
        pg8::Gemm g{(const pg8::bf16_t*)(ws + WS_ACT), (const pg8::bf16_t*)(ws + WS_WDN), M, D, DFF}; pg8::StaticOrder S; S.init(M, D, F.G, F.bid);
        pg8::EpiF32SS E{(float*)(ws + WS_MIX), (float*)(ws + WS_SS3), D};
        _Pragma("unroll 1") for (int rep = 0; rep < NREP(10); ++rep) { pg8::gemm_phase<pg8::EpiF32SS, pg8::StaticOrder, false, true>(F.lds, g, S, E); __syncthreads(); }
    } SEAM(10);
    if (IN(11)) { p11_rows(F); }
#undef IN
#undef SEAM
}

extern "C" void kernel_launch(void* const* d_in, const int* in_sizes, int n_in, void* d_out, int out_size, void* d_ws, size_t ws_size, hipStream_t stream) {
    static int grid = 0;
    if (grid == 0) {
        if (n_in != 26 || in_sizes[0] != M * D || out_size != M * D || ws_size < WS_END) { fprintf(stderr, "kernel_launch: unexpected shapes (n_in %d, in0 %d, out %d, ws %zu); nothing launched\n", n_in, n_in > 0 ? in_sizes[0] : -1, out_size, ws_size); grid = -1; return; }
        int dev = 0, cus = 0, per_cu = 0;
        if (hipGetDevice(&dev) != hipSuccess || hipDeviceGetAttribute(&cus, hipDeviceAttributeMultiprocessorCount, dev) != hipSuccess) { grid = -1; return; }
        if (hipFuncSetAttribute((const void*)fwd_kernel, hipFuncAttributeMaxDynamicSharedMemorySize, LDS_BYTES) != hipSuccess) { fprintf(stderr, "kernel_launch: hipFuncSetAttribute failed\n"); grid = -1; return; }
        if (hipOccupancyMaxActiveBlocksPerMultiprocessor(&per_cu, (const void*)fwd_kernel, NWAVES * 64, LDS_BYTES) != hipSuccess || per_cu < 1) { fprintf(stderr, "kernel_launch: occupancy query reports %d blocks per CU\n", per_cu); per_cu = 1; }
        (void)hipGetLastError();
        grid = cus;
    }
    if (grid < 0) return;
    Args a{};
    for (int i = 0; i < 26; ++i) a.in[i] = (const float*)d_in[i];
    a.out = (float*)d_out; a.ws = (unsigned char*)d_ws;
#if MK_ONE_LAUNCH
    a.ph_lo = 0; a.ph_hi = N_PHASES;
    void* kargs[] = {&a};
    hipError_t e = hipLaunchCooperativeKernel((const void*)fwd_kernel, dim3(grid), dim3(NWAVES * 64), kargs, LDS_BYTES, stream);
    if (e != hipSuccess) fprintf(stderr, "kernel_launch: cooperative launch failed: %s (grid %d)\n", hipGetErrorString(e), grid);
#else
    for (int ph = 0; ph < N_PHASES; ++ph) {
        a.ph_lo = ph; a.ph_hi = ph + 1;
        hipLaunchKernelGGL(fwd_kernel, dim3(grid), dim3(NWAVES * 64), LDS_BYTES, stream, a);
        const hipError_t le = hipPeekAtLastError();
        if (le != hipSuccess) { fprintf(stderr, "kernel_launch: launch %d failed: %s\n", ph, hipGetErrorName(le)); break; }
    }
#endif
}
```

```cpp
#include <hip/hip_runtime.h>
#include <hip/hip_cooperative_groups.h>
#include <cstdio>
#include <cstdint>
namespace cg = cooperative_groups;

namespace pg8 {
#define PG8_LAS __attribute__((address_space(3)))
typedef unsigned short bf16_t;
typedef short bf16x8 __attribute__((ext_vector_type(8)));
typedef float f32x4 __attribute__((ext_vector_type(4)));
typedef float f32x2 __attribute__((ext_vector_type(2)));
typedef unsigned u32x4 __attribute__((ext_vector_type(4)));
typedef _Float16 h16x2 __attribute__((ext_vector_type(2)));
constexpr int BM = 256, BK = 64, HALF = 128, HTB = HALF * BK * 2  , STAGE_BYTES = 8 * HTB, NXCD = 8, WGM = 8;

__host__ __device__ __forceinline__ int lds_byte(int r, int c) { const int st = (r >> 4) * 2 + (c >> 5), rr = r & 15, cc = c & 31, ob = rr * 64 + cc * 2; return st * 1024 + (ob ^ (((ob >> 9) & 1) << 5)); }
__host__ __device__ __forceinline__ void stage_rc(int b, int& R, int& C) { const int st = b / 1024, sb = b % 1024, swz = sb ^ (((sb >> 9) & 1) << 5); R = (st >> 1) * 16 + swz / 64; C = (st & 1) * 32 + (swz % 64) / 2; }
__host__ __device__ __forceinline__ int perm32(int rho) { const int n = rho >> 4, i = rho & 15; return 8 * (i >> 2) + 4 * n + (i & 3); }

struct Unit { int pm, pn; };
struct Gemm { const bf16_t* A; const bf16_t* Bt; int M, N, K; };

struct StaticOrder {
    int nM, nN, nwg, G, c;
    __host__ __device__ void init(int M, int N, int G_, int c_) { nM = M / BM; nN = N / BM; nwg = nM * nN; G = G_; c = c_; }
    __host__ __device__ __forceinline__ bool next(int i, Unit& u) const {
        const long L = (long)i * G + c; if (L >= nwg) return false;
        int wgid = (int)L; { const int q = nwg / NXCD, r = nwg % NXCD, xcd = wgid % NXCD, off = wgid / NXCD; wgid = (xcd < r ? xcd * (q + 1) : r * (q + 1) + (xcd - r) * q) + off; }
        const int nig = WGM * nN, gid = wgid / nig, fm = gid * WGM, gsz = (nM - fm) < WGM ? (nM - fm) : WGM;
        u.pm = fm + ((wgid % nig) % gsz); u.pn = (wgid % nig) / gsz; return true;
    }
    __device__ __forceinline__ const char* pa(const Gemm& g, const Unit& u) const { return (const char*)g.A + (size_t)u.pm * ((size_t)BM * g.K * 2); }
    __device__ __forceinline__ const char* pb(const Gemm& g, const Unit& u) const { return (const char*)g.Bt + (size_t)u.pn * ((size_t)BM * g.K * 2); }
    __device__ __forceinline__ void a_ready(const Unit&) const {}
    __device__ __forceinline__ void done(const Unit&) const {}
};
struct OrderG3 {
    int pm, pn0, valid; const bf16_t *a_xn, *a_oa, *a_ob;
    __device__ __forceinline__ void init(int M, int N, int G_, int c_) { StaticOrder b; b.init(M, N, G_, c_); Unit t; t.pm = 0; t.pn = 0; valid = b.next(0, t) ? 1 : 0; pm = t.pm; pn0 = t.pn; }
    __device__ __forceinline__ bool next(int i, Unit& u) const { if (i >= 4 || !valid) return false; u.pm = pm; u.pn = 4 * i + pn0; return true; }
    __device__ __forceinline__ const char* pa(const Gemm& g, const Unit& u) const { const int s = u.pn >> 2; const long long d1 = (const char*)a_oa - (const char*)a_xn, d3 = (const char*)a_ob - (const char*)a_xn; const long long off = (long long)(s == 1) * d1 + (long long)(s == 3) * d3; return (const char*)a_xn + off + (size_t)u.pm * ((size_t)BM * g.K * 2); }
    __device__ __forceinline__ const char* pb(const Gemm& g, const Unit& u) const { return (const char*)g.Bt + (size_t)u.pn * ((size_t)BM * g.K * 2); }
    __device__ __forceinline__ void a_ready(const Unit&) const {}
    __device__ __forceinline__ void done(const Unit&) const {}
};

typedef __bf16 bf16x2_t __attribute__((ext_vector_type(2)));
__device__ __forceinline__ unsigned cvt_pk_bf16(float lo, float hi) { const f32x2 v = {lo, hi}; return __builtin_bit_cast(unsigned, __builtin_convertvector(v, bf16x2_t)); }
__device__ __forceinline__ unsigned cvt_pk_f16(float lo, float hi) { h16x2 v; v.x = (_Float16)lo; v.y = (_Float16)hi; return __builtin_bit_cast(unsigned, v); }
__device__ __forceinline__ float fsigmoid(float x) { return __builtin_amdgcn_rcpf(1.0f + __expf(-x)); }

struct EpiG1 {
    static constexpr bool PERM = true, AFTER_DRAIN = false;
    bf16_t *Q, *KF, *VI, *HG, *R, *K, *V, *LZ; const float* lbraw;
    template <int MODE> __device__ __forceinline__ void tile(const f32x4 (&acc)[2][2][4][2], bf16_t* base, int ldc, int row0, int col0) const {
        float oml[2][8];
        if (MODE == 1) {
#pragma unroll
            for (int bj = 0; bj < 2; ++bj)
#pragma unroll
                for (int e = 0; e < 8; ++e) { const int c = col0 + bj * HALF + e; oml[bj][e] = fsigmoid(lbraw[1024 + c] - lbraw[c]); }
        }
#pragma unroll
        for (int ai = 0; ai < 2; ++ai)
#pragma unroll
            for (int m = 0; m < 4; ++m) { bf16_t* rowp = base + (size_t)(row0 + ai * HALF + m * 16) * ldc + col0;
#pragma unroll
                for (int bj = 0; bj < 2; ++bj) { float v[8];
#pragma unroll
                    for (int e = 0; e < 4; ++e) { v[e] = acc[ai][bj][m][0][e]; v[4 + e] = acc[ai][bj][m][1][e]; }
                    u32x4 w;
                    if (MODE == 0) {
#pragma unroll
                        for (int e = 0; e < 8; ++e) v[e] = v[e] * fsigmoid(v[e]) * 0.08838834764831845f;
                    } else if (MODE == 1) {
#pragma unroll
                        for (int e = 0; e < 8; ++e) v[e] = oml[bj][e] * fsigmoid(-v[e]);
                    } else if (MODE == 3) {
#pragma unroll
                        for (int e = 0; e < 8; ++e) v[e] = v[e] * fsigmoid(v[e]);
                    }
                    if (MODE == 1) { w.x = cvt_pk_f16(v[0], v[1]); w.y = cvt_pk_f16(v[2], v[3]); w.z = cvt_pk_f16(v[4], v[5]); w.w = cvt_pk_f16(v[6], v[7]); }
                    else { w.x = cvt_pk_bf16(v[0], v[1]); w.y = cvt_pk_bf16(v[2], v[3]); w.z = cvt_pk_bf16(v[4], v[5]); w.w = cvt_pk_bf16(v[6], v[7]); }
                    *(u32x4*)(rowp + bj * HALF) = w; } }
    }
    __device__ __forceinline__ void operator()(const f32x4 (&acc)[2][2][4][2], const Unit& u, int wr, int wc, int fr, int fq) const {
        const int pn = u.pn, row0 = u.pm * BM + wr * 64 + fr, cw = wc * 32 + 8 * fq;
        if (pn < 4) tile<0>(acc, Q, 1024, row0, pn * 256 + cw);
        else if (pn < 8) tile<1>(acc, KF, 1024, row0, (pn - 4) * 256 + cw);
        else if (pn < 12) tile<2>(acc, VI, 1024, row0, (pn - 8) * 256 + cw);
        else if (pn < 16) tile<3>(acc, HG, 1024, row0, (pn - 12) * 256 + cw);
        else if (pn < 20) tile<2>(acc, R, 1024, row0, (pn - 16) * 256 + cw);
        else if (pn < 24) tile<2>(acc, K, 1024, row0, (pn - 20) * 256 + cw);
        else if (pn < 28) tile<2>(acc, V, 1024, row0, (pn - 24) * 256 + cw);
        else tile<2>(acc, LZ, 256, row0, cw);
    }
};

struct EpiG3 {
    static constexpr bool PERM = true, AFTER_DRAIN = false;
    f32x4* scr;
    bf16_t* O;
    __device__ __forceinline__ void operator()(const f32x4 (&acc)[2][2][4][2], const Unit& u, int wr, int wc, int fr, int fq) const {
        const int s = u.pn >> 2, pn0 = u.pn & 3, tid = threadIdx.x;
        f32x4* t0 = scr + tid * 32; f32x4* t1 = scr + 32 * 512 + tid * 32;
        if (s == 0 || s == 2) { f32x4* t = s ? t1 : t0;
#pragma unroll
            for (int ai = 0; ai < 2; ++ai)
#pragma unroll
                for (int bj = 0; bj < 2; ++bj)
#pragma unroll
                    for (int m = 0; m < 4; ++m)
#pragma unroll
                        for (int n = 0; n < 2; ++n) { const f32x4 a = acc[ai][bj][m][n]; f32x4 r; r.x = fsigmoid(a.x); r.y = fsigmoid(a.y); r.z = fsigmoid(a.z); r.w = fsigmoid(a.w); t[((ai * 2 + bj) * 4 + m) * 2 + n] = r; }
        } else if (s == 1) {
#pragma unroll
            for (int ai = 0; ai < 2; ++ai)
#pragma unroll
                for (int bj = 0; bj < 2; ++bj)
#pragma unroll
                    for (int m = 0; m < 4; ++m)
                        { _Pragma("unroll") for (int n = 0; n < 2; ++n) { const int ix = ((ai * 2 + bj) * 4 + m) * 2 + n; t0[ix] = t0[ix] * acc[ai][bj][m][n]; } if (m & 1) asm volatile("" ::: "memory"); }
        } else {
            const int row0 = u.pm * BM + wr * 64 + fr, col0 = pn0 * BM + wc * 32 + 8 * fq;
#pragma unroll
            for (int ai = 0; ai < 2; ++ai)
#pragma unroll
                for (int m = 0; m < 4; ++m) { bf16_t* rowp = O + (size_t)(row0 + ai * HALF + m * 16) * 1024 + col0;
#pragma unroll
                    for (int bj = 0; bj < 2; ++bj) { const int ix = ((ai * 2 + bj) * 4 + m) * 2;
                        const f32x4 v0 = t0[ix] + t1[ix] * acc[ai][bj][m][0], v1 = t0[ix + 1] + t1[ix + 1] * acc[ai][bj][m][1];
                        u32x4 w; w.x = cvt_pk_bf16(v0[0], v0[1]); w.y = cvt_pk_bf16(v0[2], v0[3]); w.z = cvt_pk_bf16(v1[0], v1[1]); w.w = cvt_pk_bf16(v1[2], v1[3]);
                        *(u32x4*)(rowp + bj * HALF) = w; } asm volatile("" ::: "memory"); }
        }
    }
};

struct EpiF32SS {
    static constexpr bool PERM = false, AFTER_DRAIN = false;
    float* out; float* ssp; int ldc;
    __device__ __forceinline__ void operator()(const f32x4 (&acc)[2][2][4][2], const Unit& u, int wr, int wc, int fr, int fq) const {
        const int row0 = u.pm * BM + wr * 64 + fr, col0 = u.pn * BM + wc * 32 + 4 * fq;
#pragma unroll
        for (int ai = 0; ai < 2; ++ai)
#pragma unroll
            for (int m = 0; m < 4; ++m) { const int r = row0 + ai * HALF + m * 16; float s = 0.f;
#pragma unroll
                for (int bj = 0; bj < 2; ++bj)
#pragma unroll
                    for (int n = 0; n < 2; ++n) { const f32x4 x = acc[ai][bj][m][n]; s += (x[0] * x[0] + x[1] * x[1]) + (x[2] * x[2] + x[3] * x[3]); *(f32x4*)(out + (size_t)r * ldc + col0 + bj * HALF + n * 16) = x; }
                s += __shfl_xor(s, 16); s += __shfl_xor(s, 32);
                if (fq == 0) ssp[(size_t)r * 16 + u.pn * 4 + wc] = s; }
    }
};

struct EpiBf16Raw {
    static constexpr bool PERM = true, AFTER_DRAIN = false;
    bf16_t* O; int ldc;
    __device__ __forceinline__ void operator()(const f32x4 (&acc)[2][2][4][2], const Unit& u, int wr, int wc, int fr, int fq) const {
        const int row0 = u.pm * BM + wr * 64 + fr, col0 = u.pn * BM + wc * 32 + 8 * fq;
#pragma unroll
        for (int ai = 0; ai < 2; ++ai)
#pragma unroll
            for (int m = 0; m < 4; ++m) { bf16_t* rowp = O + (size_t)(row0 + ai * HALF + m * 16) * ldc + col0;
#pragma unroll
                for (int bj = 0; bj < 2; ++bj) { const f32x4 v0 = acc[ai][bj][m][0], v1 = acc[ai][bj][m][1];
                    u32x4 w; w.x = cvt_pk_bf16(v0[0], v0[1]); w.y = cvt_pk_bf16(v0[2], v0[3]); w.z = cvt_pk_bf16(v1[0], v1[1]); w.w = cvt_pk_bf16(v1[2], v1[3]);
                    *(u32x4*)(rowp + bj * HALF) = w; } }
    }
};

template <class Epi, class Sched, bool ALIGN_EPI = false, bool SP2 = false>
__device__ __forceinline__ void gemm_phase(PG8_LAS unsigned char* lds, const Gemm g, const Sched& S, const Epi& E) {
    const int tid = threadIdx.x, wid = __builtin_amdgcn_readfirstlane(tid >> 6), lane = tid & 63, wr = wid >> 2, wc = wid & 3, fr = lane & 15, fq = lane >> 4;
    const int K = g.K, nt = K / BK;
    unsigned voffA[2], voffB[2];
#pragma unroll
    for (int i = 0; i < 2; ++i) { int R, C; stage_rc(tid * 16 + i * 8192, R, C); const int Rb = Epi::PERM ? ((R & ~31) + perm32(R & 31)) : R;
        voffA[i] = (unsigned)(R * K + C) * 2u; voffB[i] = (unsigned)(Rb * K + C) * 2u; }
    const size_t kstep = (size_t)(BK * 2);
    const size_t hstep = (size_t)HALF * K * 2;
    const size_t tstep = 2 * hstep;
    const unsigned ldsw = (unsigned)wid * 1024u;
    const int aoff = lds_byte(wr * 64 + fr, fq * 8), boff = lds_byte(wc * 32 + fr, fq * 8);
#define PG8_SA(b, h) (((b) * 2 + (h)) * HTB)
#define PG8_SB(b, h) ((4 + (b) * 2 + (h)) * HTB)
#define PG8_STAGE(bufoff, gbase, voff) do { _Pragma("unroll") for (int _i = 0; _i < 2; ++_i) \
        __builtin_amdgcn_global_load_lds((const unsigned*)((const char*)(gbase) + (voff)[_i]), (PG8_LAS unsigned*)(lds + (bufoff) + ldsw + _i * 8192), 16, 0, 0); } while (0)
#define PG8_LDA(dst, b, h) do { _Pragma("unroll") for (int m = 0; m < 4; ++m) _Pragma("unroll") for (int k = 0; k < 2; ++k) dst[m][k] = *(const PG8_LAS bf16x8*)(lds + PG8_SA(b, h) + aoff + m * 2048 + k * 1024); } while (0)
#define PG8_LDB(dst, b, h) do { _Pragma("unroll") for (int n = 0; n < 2; ++n) _Pragma("unroll") for (int k = 0; k < 2; ++k) dst[n][k] = *(const PG8_LAS bf16x8*)(lds + PG8_SB(b, h) + boff + n * 2048 + k * 1024); } while (0)
#define PG8_MMA(ai, bj, At, Bt) do { __builtin_amdgcn_s_setprio(1); _Pragma("unroll") for (int m = 0; m < 4; ++m) _Pragma("unroll") for (int n = 0; n < 2; ++n) _Pragma("unroll") for (int k = 0; k < 2; ++k) \
        acc[ai][bj][m][n] = __builtin_amdgcn_mfma_f32_16x16x32_bf16(Bt[n][k], At[m][k], acc[ai][bj][m][n], 0, 0, 0); __builtin_amdgcn_s_setprio(0); } while (0)
#define PG8_WAIT_V(n) asm volatile("s_waitcnt vmcnt(" #n ")" ::: "memory")
#define PG8_WAIT_L(n) asm volatile("s_waitcnt lgkmcnt(" #n ")" ::: "memory")
#define PG8_BAR __builtin_amdgcn_s_barrier()
#define PG8_SCHED __builtin_amdgcn_sched_barrier(0)
    Unit cur, nxt; int ui = 0;
    if (!S.next(0, cur)) return;
    f32x4 acc[2][2][4][2];
#pragma unroll
    for (int a = 0; a < 2; ++a)
#pragma unroll
        for (int b = 0; b < 2; ++b)
#pragma unroll
            for (int m = 0; m < 4; ++m)
#pragma unroll
                for (int n = 0; n < 2; ++n) acc[a][b][m][n] = (f32x4){0.f, 0.f, 0.f, 0.f};
    bf16x8 At[4][2], B0[2][2], B1[2][2];
    const char* cA = S.pa(g, cur); const char* cB = S.pb(g, cur);
    S.a_ready(cur);
    if constexpr (SP2) {
        PG8_STAGE(PG8_SB(0, 0), cB, voffB); PG8_STAGE(PG8_SB(0, 1), cB + hstep, voffB); PG8_STAGE(PG8_SA(0, 0), cA, voffA); PG8_STAGE(PG8_SA(0, 1), cA + hstep, voffA);
        if (wr == 1) PG8_BAR;
        PG8_WAIT_V(2); PG8_BAR;
        PG8_STAGE(PG8_SB(1, 0), cB + kstep, voffB); PG8_STAGE(PG8_SA(1, 0), cA + kstep, voffA); PG8_STAGE(PG8_SB(1, 1), cB + hstep + kstep, voffB);
        PG8_WAIT_V(6); PG8_BAR;
    } else {
        PG8_STAGE(PG8_SB(0, 0), cB, voffB); PG8_STAGE(PG8_SA(0, 0), cA, voffA); PG8_STAGE(PG8_SB(0, 1), cB + hstep, voffB); PG8_STAGE(PG8_SA(0, 1), cA + hstep, voffA);
        if (wr == 1) PG8_BAR;
        PG8_WAIT_V(4); PG8_BAR;
        PG8_STAGE(PG8_SB(1, 0), cB + kstep, voffB); PG8_STAGE(PG8_SA(1, 0), cA + kstep, voffA); PG8_STAGE(PG8_SB(1, 1), cB + hstep + kstep, voffB);
        PG8_WAIT_V(6); PG8_BAR;
    }
    for (;;) {
        const bool has_next = S.next(ui + 1, nxt);
        const char* nA = has_next ? S.pa(g, nxt) : cA; const char* nB = has_next ? S.pb(g, nxt) : cB;
        for (int t = 0; t < nt; t += 2) {
            const bool last = (t == nt - 2);
            const char* a1 = cA + (size_t)(t + 1) * kstep;
            const char* a2 = last ? nA : cA + (size_t)(t + 2) * kstep; const char* b2 = last ? nB : cB + (size_t)(t + 2) * kstep;
            const char* a3 = a2 + kstep; const char* b3 = b2 + kstep;
            if (last && has_next) S.a_ready(nxt);
            if constexpr (SP2) {
            PG8_LDB(B0, 0, 0); PG8_LDB(B1, 0, 1); PG8_SCHED; PG8_LDA(At, 0, 0); PG8_STAGE(PG8_SA(1, 1), a1 + hstep, voffA);
            PG8_WAIT_V(8); PG8_WAIT_L(0); PG8_BAR; PG8_MMA(0, 0, At, B0); PG8_MMA(0, 1, At, B1); PG8_BAR; PG8_SCHED;
            PG8_LDA(At, 0, 1); PG8_STAGE(PG8_SB(0, 0), b2, voffB); PG8_STAGE(PG8_SB(0, 1), b2 + hstep, voffB); PG8_STAGE(PG8_SA(0, 0), a2, voffA);
            PG8_WAIT_V(8); PG8_WAIT_L(0); PG8_BAR; PG8_MMA(1, 0, At, B0); PG8_MMA(1, 1, At, B1); PG8_BAR; PG8_SCHED;
            PG8_LDB(B0, 1, 0); PG8_LDB(B1, 1, 1); PG8_SCHED; PG8_LDA(At, 1, 0); PG8_STAGE(PG8_SA(0, 1), a2 + hstep, voffA);
            PG8_WAIT_V(8); PG8_WAIT_L(0); PG8_BAR; PG8_MMA(0, 0, At, B0); PG8_MMA(0, 1, At, B1); PG8_BAR; PG8_SCHED;
            PG8_LDA(At, 1, 1); PG8_STAGE(PG8_SB(1, 0), b3, voffB); PG8_STAGE(PG8_SB(1, 1), b3 + hstep, voffB); PG8_STAGE(PG8_SA(1, 0), a3, voffA);
            PG8_WAIT_V(8); PG8_WAIT_L(0); PG8_BAR; PG8_MMA(1, 0, At, B0); PG8_MMA(1, 1, At, B1); PG8_BAR; PG8_SCHED;
            } else {
            PG8_LDB(B0, 0, 0); PG8_SCHED; PG8_LDA(At, 0, 0); PG8_STAGE(PG8_SA(1, 1), a1 + hstep, voffA);
            PG8_WAIT_L(8); PG8_BAR; PG8_WAIT_L(0); PG8_MMA(0, 0, At, B0); PG8_BAR; PG8_SCHED;
            PG8_LDB(B1, 0, 1); PG8_STAGE(PG8_SB(0, 0), b2, voffB);
            PG8_BAR; PG8_WAIT_L(0); PG8_MMA(0, 1, At, B1); PG8_BAR;
            PG8_LDA(At, 0, 1); PG8_STAGE(PG8_SA(0, 0), a2, voffA);
            PG8_BAR; PG8_WAIT_L(0); PG8_MMA(1, 0, At, B0); PG8_BAR; PG8_SCHED;
            PG8_STAGE(PG8_SB(0, 1), b2 + hstep, voffB);
            PG8_WAIT_V(6); PG8_BAR; PG8_MMA(1, 1, At, B1); PG8_BAR;
            PG8_LDB(B0, 1, 0); PG8_SCHED; PG8_LDA(At, 1, 0); PG8_STAGE(PG8_SA(0, 1), a2 + hstep, voffA);
            PG8_WAIT_L(8); PG8_BAR; PG8_WAIT_L(0); PG8_MMA(0, 0, At, B0); PG8_BAR; PG8_SCHED;
            PG8_LDB(B1, 1, 1); PG8_STAGE(PG8_SB(1, 0), b3, voffB);
            PG8_BAR; PG8_WAIT_L(0); PG8_MMA(0, 1, At, B1); PG8_BAR;
            PG8_LDA(At, 1, 1); PG8_STAGE(PG8_SA(1, 0), a3, voffA);
            PG8_BAR; PG8_WAIT_L(0); PG8_MMA(1, 0, At, B0); PG8_BAR; PG8_SCHED;
            PG8_STAGE(PG8_SB(1, 1), b3 + hstep, voffB);
            PG8_WAIT_V(6); PG8_BAR; PG8_MMA(1, 1, At, B1); PG8_BAR;
            }
        }
        if constexpr (ALIGN_EPI) { if (wr == 0) PG8_BAR; }
        if constexpr (!Epi::AFTER_DRAIN) { E(acc, cur, wr, wc, fr, fq); S.done(cur); }
        if (!has_next) break;
#pragma unroll
        for (int a = 0; a < 2; ++a)
#pragma unroll
            for (int b = 0; b < 2; ++b)
#pragma unroll
                for (int m = 0; m < 4; ++m)
#pragma unroll
                    for (int n = 0; n < 2; ++n) acc[a][b][m][n] = (f32x4){0.f, 0.f, 0.f, 0.f};
        cur = nxt; cA = nA; cB = nB; ++ui;
        if constexpr (ALIGN_EPI) { if (wr == 1) PG8_BAR; }
    }
    PG8_WAIT_V(0);
    if constexpr (!ALIGN_EPI) { if (wr == 0) PG8_BAR; }
    PG8_BAR;
    if constexpr (Epi::AFTER_DRAIN) { E.fused(acc, cur, wr, wc, fr, fq, lds, wid, lane); S.done(cur); }
#undef PG8_SA
#undef PG8_SB
#undef PG8_STAGE
#undef PG8_LDA
#undef PG8_LDB
#undef PG8_MMA
#undef PG8_WAIT_V
#undef PG8_WAIT_L
#undef PG8_BAR
#undef PG8_SCHED
}
}

constexpr int NWAVES = 8;
#ifndef MK_ONE_LAUNCH
#define MK_ONE_LAUNCH 1
#endif
constexpr int N_PHASES = 12;

constexpr int BATCH = 8, SEQ = 2048, D = 1024, M = BATCH * SEQ;
constexpr int IN_COLS = 9472, N1 = 7424;
constexpr int DFF = 2816, NUP = 2 * DFF;
constexpr int MH = M / 2;
constexpr float EPS = 1e-6f, GN_EPS = 64e-5f;

constexpr size_t MiB = 1u << 20;
constexpr size_t WS_CTL = 0;
constexpr size_t WS_W1 = 1 * MiB, WS_W3 = 16 * MiB, WS_WOUT = 24 * MiB, WS_WUP = 26 * MiB, WS_WDN = 37 * MiB, WS_LORA = 43 * MiB;
constexpr size_t WS_Q = 44 * MiB, WS_KF = 76 * MiB, WS_HG = 108 * MiB, WS_R = 140 * MiB, WS_K = 172 * MiB, WS_LZ = 204 * MiB, WS_VI = 212 * MiB;
constexpr size_t WS_SS1 = 244 * MiB, WS_SS3 = 252 * MiB;
constexpr size_t WS_SCR = 76 * MiB;
constexpr size_t WS_MRG = WS_Q;
constexpr size_t WS_MIX = 76 * MiB;
constexpr size_t WS_HB = WS_Q;
constexpr size_t WS_HU = 76 * MiB;
constexpr size_t WS_ACT = 164 * MiB;
constexpr size_t WS_END = 256 * MiB;
constexpr size_t OUT_XN = 0, OUT_V = 32 * MiB;

constexpr int LDS_BYTES = 147456;

#define GAS __attribute__((address_space(1)))
#define LAS __attribute__((address_space(3)))
typedef unsigned short bf16;
typedef unsigned v4u __attribute__((ext_vector_type(4)));
typedef unsigned v2u __attribute__((ext_vector_type(2)));
typedef float f32x4 __attribute__((ext_vector_type(4)));
typedef float f32x2 __attribute__((ext_vector_type(2)));
typedef short bf16x8 __attribute__((ext_vector_type(8)));
#define LDS_WAIT() asm volatile("s_waitcnt lgkmcnt(0)" ::: "memory")
#define VM_WAIT() asm volatile("s_waitcnt vmcnt(0)" ::: "memory")
__device__ __forceinline__ unsigned f2bf(float f) { return (unsigned)__builtin_bit_cast(unsigned short, (__bf16)f); }
__device__ __forceinline__ unsigned pk2(float lo, float hi) { return pg8::cvt_pk_bf16(lo, hi); }
__device__ __forceinline__ float bf_lo(unsigned u) { return __builtin_bit_cast(float, u << 16); }
__device__ __forceinline__ float bf_hi(unsigned u) { return __builtin_bit_cast(float, u & 0xffff0000u); }
__device__ __forceinline__ float bf1(unsigned short u) { return __builtin_bit_cast(float, (unsigned)u << 16); }
__device__ __forceinline__ float h1(unsigned short u) { return (float)__builtin_bit_cast(_Float16, u); }
__device__ __forceinline__ float fsig(float x) { return __builtin_amdgcn_rcpf(1.0f + __expf(-x)); }
__device__ __forceinline__ float wave_sum(float v) {
#pragma unroll
    for (int o = 1; o < 64; o <<= 1) v += __shfl_xor(v, o);
    return v;
}
template <int CTRL> __device__ __forceinline__ float dpp_f(float x) { return __builtin_bit_cast(float, __builtin_amdgcn_mov_dpp(__builtin_bit_cast(int, x), CTRL, 0xf, 0xf, false)); }
__device__ __forceinline__ float red16(float x) {
    x += dpp_f<0x128>(x); x += dpp_f<0x124>(x); x += dpp_f<0x122>(x); x += dpp_f<0x121>(x); return x;
}

#define XB_TMO      128
#define XB_XCNT(j)  (256  + 64 * (j))
#define XB_XSUB(j)  (1280 + 64 * (j))
#define XB_XGEN(j)  (2304 + 64 * (j))
#define XB_TOP      3328
#define XB_TOPGEN   3392
#define XCD_BAR_WORDS 3456
#define XB_SPIN_CAP (1u << 18)

__device__ __forceinline__ unsigned xb_ld(unsigned* p)              { return __hip_atomic_load(p, __ATOMIC_RELAXED, __HIP_MEMORY_SCOPE_AGENT); }
__device__ __forceinline__ unsigned xb_add(unsigned* p, unsigned v) { return __hip_atomic_fetch_add(p, v, __ATOMIC_RELAXED, __HIP_MEMORY_SCOPE_AGENT); }
__device__ __forceinline__ unsigned xb_xcc_id() { return (unsigned)__builtin_amdgcn_s_getreg((3 << 11) | 20) & 0xFu; }
#define XB_SPIN(cond, bar) do { unsigned _sp = 0; while (cond) { __builtin_amdgcn_s_sleep(1); \
    if ((++_sp & 255u) == 0u) { if (xb_ld(&(bar)[XB_TMO])) break; if (_sp > XB_SPIN_CAP) { atomicAdd(&(bar)[XB_TMO], 1u); break; } } } } while (0)

struct XcdBarrier {
    unsigned* bar; unsigned x;
    volatile LAS unsigned* st;
};

__device__ __forceinline__ XcdBarrier xcd_barrier_post(unsigned* bar, volatile LAS unsigned* st) {
    XcdBarrier b; b.bar = bar; b.x = xb_xcc_id(); b.st = st;
    if (threadIdx.x == 0) (void)xb_add(&bar[XB_XCNT(b.x)], 1u);
    return b;
}
__device__ __forceinline__ void xcd_barrier_complete(unsigned* bar, unsigned x, unsigned& nloc, unsigned& nx) {
    const unsigned G = gridDim.x * gridDim.y * gridDim.z;
    unsigned sum, cnt, mine, sp = 0u;
    for (;;) {
        sum = 0u; cnt = 0u; mine = 0u;
#pragma unroll
        for (unsigned j = 0; j < 16; ++j) { const unsigned c = xb_ld(&bar[XB_XCNT(j)]); sum += c; cnt += (c > 0u) ? 1u : 0u; mine = (j == x) ? c : mine; }
        if (sum == G) break;
        __builtin_amdgcn_s_sleep(1);
        if ((++sp & 255u) == 0u) { if (xb_ld(&bar[XB_TMO])) break; if (sp > XB_SPIN_CAP) { atomicAdd(&bar[XB_TMO], 1u); break; } }
    }
    nloc = mine > 0u ? mine : 1u; nx = cnt > 0u ? cnt : 1u;
}

__device__ __forceinline__ void xcd_barrier(const XcdBarrier& b) {
    asm volatile("s_waitcnt vmcnt(0)" ::: "memory");
    __syncthreads();
    if (threadIdx.x == 0) {
        unsigned* bar = b.bar;
        __builtin_amdgcn_s_waitcnt(0);
        unsigned nloc = b.st[0], nx = b.st[1];
        if (nloc == 0u) { xcd_barrier_complete(bar, b.x, nloc, nx); b.st[0] = nloc; b.st[1] = nx; }
        const unsigned old = xb_add(&bar[XB_XSUB(b.x)], 1u);
        const unsigned gen = old / nloc;
        if (old + 1u == (gen + 1u) * nloc) {
            __builtin_amdgcn_fence(__ATOMIC_RELEASE, "agent");
            asm volatile("s_waitcnt vmcnt(0)" ::: "memory");
            const unsigned og = xb_add(&bar[XB_TOP], 1u);
            const unsigned tg = og / nx;
            if (og + 1u == (tg + 1u) * nx) xb_add(&bar[XB_TOPGEN], 1u);
            else XB_SPIN(xb_ld(&bar[XB_TOPGEN]) == tg, bar);
            __builtin_amdgcn_fence(__ATOMIC_ACQUIRE, "agent");
            xb_add(&bar[XB_XGEN(b.x)], 1u);
            asm volatile("s_waitcnt vmcnt(0)" ::: "memory");
        } else {
            XB_SPIN(xb_ld(&bar[XB_XGEN(b.x)]) == gen, bar);
            __builtin_amdgcn_fence(__ATOMIC_ACQUIRE, "agent");
            asm volatile("s_waitcnt vmcnt(0)" ::: "memory");
        }
    }
    __syncthreads();
}


constexpr int CW_BAR = 4096;
constexpr int MISC_OFF = LDS_BYTES - 64;

struct Frame {
    LAS unsigned char* lds;
    int tid, lane, wave, G, bid;
    const float* in[26]; float* out; unsigned char* ws;
};

__device__ __forceinline__ void p0_tr_item(const float* W, int ldw, int n0, int K, bf16* WT, int r0, int nblk, LAS float* scr, int item, int lane) {
    const int kb = item / nblk, nb = item % nblk, k0 = 64 * kb, nn = 32 * nb;
#pragma unroll 8
    for (int i = 0; i < 32; ++i) { const int kk = 2 * i + (lane >> 5); scr[kk * 33 + (lane & 31)] = W[(size_t)(k0 + kk) * ldw + n0 + nn + (lane & 31)]; }
    LDS_WAIT(); asm volatile("" ::: "memory");
    const int c = lane & 7;
#pragma unroll
    for (int j = 0; j < 4; ++j) { const int n = (lane >> 3) + 8 * j; const LAS float* s = scr + (8 * c) * 33 + n;
        v4u o; o.x = pk2(s[0 * 33], s[1 * 33]); o.y = pk2(s[2 * 33], s[3 * 33]); o.z = pk2(s[4 * 33], s[5 * 33]); o.w = pk2(s[6 * 33], s[7 * 33]);
        *(GAS v4u*)(WT + (size_t)(r0 + nn + n) * K + k0 + 8 * c) = o; }
    LDS_WAIT(); asm volatile("" ::: "memory");
}
__device__ __forceinline__ void rms_row_to_bf16(int lane, const float* xrow, const float* g, bf16* orow) {
    const GAS f32x4* xr = (const GAS f32x4*)xrow + lane; const GAS f32x4* gr = (const GAS f32x4*)g + lane;
    f32x4 v[4]; float s = 0.f;
#pragma unroll
    for (int j = 0; j < 4; ++j) { v[j] = xr[64 * j]; s += (v[j].x * v[j].x + v[j].y * v[j].y) + (v[j].z * v[j].z + v[j].w * v[j].w); }
    const float rstd = __builtin_amdgcn_rsqf(wave_sum(s) * (1.f / D) + EPS);
    GAS unsigned long long* o8 = (GAS unsigned long long*)orow + lane;
#pragma unroll
    for (int j = 0; j < 4; ++j) { const f32x4 gg = gr[64 * j]; o8[64 * j] = (unsigned long long)pk2(v[j].x * rstd * gg.x, v[j].y * rstd * gg.y) | ((unsigned long long)pk2(v[j].z * rstd * gg.z, v[j].w * rstd * gg.w) << 32); }
}
__device__ __forceinline__ void p0_prologue(Frame& F) {
    LAS float* scr = (LAS float*)(F.lds + F.wave * 16384);
    const int gw = F.bid * NWAVES + F.wave, NGW = F.G * NWAVES;
    const float* w_in = F.in[2];
    bf16* W1 = (bf16*)(F.ws + WS_W1); bf16* W3 = (bf16*)(F.ws + WS_W3); bf16* WO = (bf16*)(F.ws + WS_WOUT); bf16* WU = (bf16*)(F.ws + WS_WUP); bf16* WD = (bf16*)(F.ws + WS_WDN);
    bf16* L2 = (bf16*)(F.ws + WS_LORA);
    constexpr int I_A = 16 * (N1 / 32), I_G = 16 * 32, I_UP = 16 * (NUP / 32), I_DN = (DFF / 64) * 32, I_L64 = 32, I_L128 = 64;
    constexpr int NITEMS = I_A + 5 * I_G + I_UP + I_DN + 2 * I_L64 + I_L128;
    for (int it = gw; it < NITEMS; it += NGW) {
        int r = it;
        if (r < I_A) { p0_tr_item(w_in, IN_COLS, 0, D, W1, 0, N1 / 32, scr, r, F.lane); continue; } r -= I_A;
        if (r < I_G) { p0_tr_item(w_in, IN_COLS, N1, D, W3, 0, 32, scr, r, F.lane); continue; } r -= I_G;
        if (r < I_G) { p0_tr_item(F.in[5], D, 0, D, W3, 1024, 32, scr, r, F.lane); continue; } r -= I_G;
        if (r < I_G) { p0_tr_item(w_in, IN_COLS, N1 + 1024, D, W3, 2048, 32, scr, r, F.lane); continue; } r -= I_G;
        if (r < I_G) { p0_tr_item(F.in[17], D, 0, D, W3, 3072, 32, scr, r, F.lane); continue; } r -= I_G;
        if (r < I_G) { p0_tr_item(F.in[18], D, 0, D, WO, 0, 32, scr, r, F.lane); continue; } r -= I_G;
        if (r < I_UP) { p0_tr_item(F.in[21], NUP, 0, D, WU, 0, NUP / 32, scr, r, F.lane); continue; } r -= I_UP;
        if (r < I_DN) { p0_tr_item(F.in[24], D, 0, DFF, WD, 0, 32, scr, r, F.lane); continue; } r -= I_DN;
        if (r < I_L64) { p0_tr_item(F.in[8], D, 0, 64, L2, 0, 32, scr, r, F.lane); continue; } r -= I_L64;
        if (r < I_L64) { p0_tr_item(F.in[10], D, 0, 64, L2 + 65536, 0, 32, scr, r, F.lane); continue; } r -= I_L64;
        p0_tr_item(F.in[11], D, 0, 128, L2 + 131072, 0, 32, scr, r, F.lane);
    }
    bf16* XN = (bf16*)((unsigned char*)F.out + OUT_XN);
    for (int m = gw; m < M; m += NGW) rms_row_to_bf16(F.lane, F.in[0] + (size_t)m * D, F.in[1], XN + (size_t)m * D);
}

__device__ __forceinline__ unsigned pk2r(float lo, float hi) { return pg8::cvt_pk_bf16(lo, hi); }
__device__ __forceinline__ bf16x8 mk8(unsigned a, unsigned b, unsigned c, unsigned d) { v4u u = {a, b, c, d}; return __builtin_bit_cast(bf16x8, u); }
__device__ __forceinline__ bf16x8 op4(const pg8::f32x4 x) { return mk8(pk2r(x[0], x[1]), pk2r(x[2], x[3]), 0u, 0u); }
__device__ __forceinline__ bf16x8 op44(const pg8::f32x4 x, const pg8::f32x4 y) { return mk8(pk2r(x[0], x[1]), pk2r(x[2], x[3]), pk2r(y[0], y[1]), pk2r(y[2], y[3])); }
#define MFMA16(a, b, c) __builtin_amdgcn_mfma_f32_16x16x32_bf16((a), (b), (c), 0, 0, 0)
__device__ __forceinline__ void rwkv_phase(Frame& F, int bh, bool dry) {
    typedef pg8::f32x4 f4;
    const int b = bh >> 4, h = bh & 15, tid = F.tid, lane = F.lane, wv = F.wave, fr = lane & 15, fq = lane >> 4;
    LAS unsigned char* L = F.lds;
    constexpr int SLOT = 17664, O_AR = 0, O_BKY = 4608, O_BTK = 9216, O_VF = 13312, O_A2 = 15360, O_M2 = 16384, O_WC = 17408, O_MU = 8 * SLOT, O_CST = O_MU + 1024, O_CARRY = O_CST + 2560;
    const bf16* L2 = (const bf16*)(F.ws + WS_LORA);
    const size_t rowbase = (size_t)b * SEQ;
    const GAS char* bR = (const GAS char*)(F.ws + WS_R) + (rowbase * D + h * 64) * 2; const GAS char* bK = (const GAS char*)(F.ws + WS_K) + (rowbase * D + h * 64) * 2;
    const GAS char* bV = (const GAS char*)((unsigned char*)F.out + OUT_V) + (rowbase * D + h * 64) * 2; GAS char* bO = (GAS char*)((unsigned char*)F.out + OUT_V) + (rowbase * D + h * 64) * 2;
    const GAS char* bLZ = (const GAS char*)(F.ws + WS_LZ) + rowbase * 512;
    const GAS char* bW2 = (const GAS char*)L2 + (size_t)h * 64 * 128, *bA2 = (const GAS char*)L2 + 131072 + (size_t)h * 64 * 128, *bG2 = (const GAS char*)L2 + 262144 + (size_t)h * 64 * 256;
    const float* mu = F.in[6];
    if (tid < 256) ((LAS float*)(L + O_MU))[tid] = mu[3072 + tid];
    for (int u = tid; u < 640; u += 512) { const int c = u >> 6, col = h * 64 + (u & 63);
        const float val = c == 0 ? F.in[7][col] : c == 1 ? F.in[9][col] : c == 2 ? F.in[12][col] : c == 3 ? F.in[13][col] : c == 4 ? F.in[14][col] : c == 5 ? F.in[15][col] : c == 6 ? F.in[16][col] : c == 7 ? mu[col] : c == 8 ? mu[1024 + col] : mu[2048 + col];
        ((LAS float*)(L + O_CST))[u] = val; }
#define CST(c, nt) (((const LAS float*)(L + O_CST))[(c) * 64 + 16 * (nt) + fr])
    LAS unsigned char* myslot = L + wv * SLOT;
    f4 St[4];
#pragma unroll
    for (int t = 0; t < 4; ++t) St[t] = (f4){0.f, 0.f, 0.f, 0.f};
    v4u lzc[8], lzq;
#define RW_LOAD_LZ(T0) do { const int tt0 = (T0); const unsigned tpv = (unsigned)(tt0 > 0 ? tt0 - 1 : 0); const unsigned oc = (unsigned)(tt0 + fr) * 512u + fq * 16u; \
        _Pragma("unroll") for (int s = 0; s < 8; ++s) lzc[s] = *(const GAS v4u*)(bLZ + (oc + s * 64u)); \
        lzq = *(const GAS v4u*)(bLZ + (tpv * 512u + (lane & 31) * 16u)); } while (0)
#define RW_LOAD_RKV(T0) do { const int tt0 = (T0); const unsigned tpv = (unsigned)(tt0 > 0 ? tt0 - 1 : 0); \
        _Pragma("unroll") for (int jj = 0; jj < 2; ++jj) { const int q = lane + 64 * jj; const unsigned o = (unsigned)(tt0 + (q >> 3)) * 2048u + (q & 7) * 16u; \
            rkv[jj] = *(const GAS v4u*)(bR + o); rkv[2 + jj] = *(const GAS v4u*)(bK + o); rkv[4 + jj] = *(const GAS v4u*)(bV + o); } \
        { const GAS char* pb_ = lane < 8 ? bR : lane < 16 ? bK : bV; rkv[6] = *(const GAS v4u*)(pb_ + (tpv * 2048u + (lane & 7) * 16u)); } } while (0)
    RW_LOAD_LZ(16 * wv);
    unsigned ggp[4][2]; float bonus[4];
    __syncthreads();
    const int lane_o = lane;
    for (int rnd = 0; rnd < SEQ / 128; ++rnd) {
        const int t0 = rnd * 128 + 16 * wv;
        int oz_; asm volatile("v_mov_b32 %0, 0" : "=v"(oz_));
        const int lane = lane_o + oz_, fr = lane & 15, fq = lane >> 4;
        {   v4u rkv[7];
            RW_LOAD_RKV(t0);
            if (lane < 32) *(LAS v4u*)(myslot + 6800 + lane * 16) = (t0 == 0) ? (v4u){0u, 0u, 0u, 0u} : lzq;
            LDS_WAIT(); asm volatile("" ::: "memory");
            bf16x8 afr[8];
#pragma unroll
            for (int s = 0; s < 8; ++s) { const LAS f4* mp = (const LAS f4*)(L + O_MU + (32 * s + 8 * fq) * 4); const f4 m0 = mp[0], m1 = mp[1];
                float x[8]; const v4u cy = *(const LAS v4u*)(myslot + 6800 + (4 * s + fq) * 16); const unsigned cu[4] = {lzc[s].x, lzc[s].y, lzc[s].z, lzc[s].w}, cyu[4] = {cy.x, cy.y, cy.z, cy.w}; unsigned pu[4];
#pragma unroll
                for (int e = 0; e < 4; ++e) { const unsigned sh = (unsigned)__builtin_amdgcn_mov_dpp((int)cu[e], 0x111, 0xf, 0xf, true); pu[e] = fr == 0 ? cyu[e] : sh; }
#pragma unroll
                for (int e = 0; e < 4; ++e) { const float z0 = bf_lo(cu[e]), z1 = bf_hi(cu[e]), p0 = bf_lo(pu[e]), p1 = bf_hi(pu[e]); const float ma = e < 2 ? m0[2 * e] : m1[2 * e - 4], mb = e < 2 ? m0[2 * e + 1] : m1[2 * e - 3];
                    x[2 * e] = z0 + ma * (p0 - z0); x[2 * e + 1] = z1 + mb * (p1 - z1); }
                if (s < 2) {
#pragma unroll
                    for (int e = 0; e < 8; ++e) x[e] = 1.f - 2.f * __builtin_amdgcn_rcpf(__expf(2.f * x[e]) + 1.f);
                } else if (s >= 4) {
#pragma unroll
                    for (int e = 0; e < 8; ++e) x[e] = fsig(x[e]);
                }
                afr[s] = mk8(pk2r(x[0], x[1]), pk2r(x[2], x[3]), pk2r(x[4], x[5]), pk2r(x[6], x[7])); }
            __builtin_amdgcn_sched_barrier(0);
#pragma unroll
            for (int jj = 0; jj < 2; ++jj) { const int q = lane + 64 * jj;
#pragma unroll
                for (int x3 = 0; x3 < 3; ++x3) *(LAS v4u*)(myslot + (1 + (q >> 3)) * 400 + x3 * 128 + (q & 7) * 16) = rkv[2 * x3 + jj]; }
            { v4u pr = rkv[6];
              if (wv == 0 && rnd > 0 && lane >= 16 && lane < 24) pr = *(const LAS v4u*)(L + O_CARRY + ((rnd - 1) & 1) * 128 + (lane & 7) * 16);
              if (wv == 7 && lane >= 56) *(LAS v4u*)(L + O_CARRY + (rnd & 1) * 128 + (lane - 56) * 16) = rkv[5];
              if (lane < 24) *(LAS v4u*)(myslot + (lane >> 3) * 128 + (lane & 7) * 16) = (t0 == 0) ? (v4u){0u, 0u, 0u, 0u} : pr; }
            LDS_WAIT(); asm volatile("" ::: "memory");
            __builtin_amdgcn_sched_barrier(0);
            float wd[4][4], asg[4][4];
            bf16x8 bq[2][8];
#define RW_LDB(dst, NT) do { const unsigned o64 = (unsigned)(16 * (NT) + fr) * 128u + fq * 16u, o128 = (unsigned)(16 * (NT) + fr) * 256u + fq * 16u; \
                _Pragma("unroll") for (int s = 0; s < 2; ++s) { dst[s] = *(const GAS bf16x8*)(bW2 + (o64 + s * 64u)); dst[2 + s] = *(const GAS bf16x8*)(bA2 + (o64 + s * 64u)); } \
                _Pragma("unroll") for (int s = 0; s < 4; ++s) dst[4 + s] = *(const GAS bf16x8*)(bG2 + (o128 + s * 64u)); } while (0)
            RW_LDB(bq[0], 0);
#pragma unroll
            for (int nt = 0; nt < 4; ++nt) {
                if (nt < 3) RW_LDB(bq[(nt + 1) & 1], nt + 1);
                asm volatile("" ::: "memory");
                f4 cw = {0.f, 0.f, 0.f, 0.f}, ca = cw, cgt = cw;
#pragma unroll
                for (int s = 0; s < 2; ++s) { cw = MFMA16(afr[s], bq[nt & 1][s], cw); ca = MFMA16(afr[2 + s], bq[nt & 1][2 + s], ca); }
#pragma unroll
                for (int s = 0; s < 4; ++s) cgt = MFMA16(afr[4 + s], bq[nt & 1][4 + s], cgt);
#pragma unroll
                for (int j = 0; j < 4; ++j) { const float wp = CST(0, nt) + cw[j]; const float wl = fminf(wp, 0.f) - __logf(1.f + __expf(-fabsf(wp))) - 0.5f;
                    wd[nt][j] = __expf(-__expf(wl)); asg[nt][j] = fsig(CST(1, nt) + ca[j]); }
                ggp[nt][0] = pk2r(cgt[0], cgt[1]); ggp[nt][1] = pk2r(cgt[2], cgt[3]);
                __builtin_amdgcn_sched_barrier(0); }
#undef RW_LDB
            __builtin_amdgcn_sched_barrier(0);
            float rl[4][4], kx[4][4], vv[4][4];
            float n2[4] = {0.f, 0.f, 0.f, 0.f}, bo[4] = {0.f, 0.f, 0.f, 0.f};
#pragma unroll
            for (int nt = 0; nt < 4; ++nt)
#pragma unroll
                for (int j = 0; j < 4; ++j) { const LAS unsigned short* sg = (const LAS unsigned short*)myslot + (4 * fq + j) * 200 + 16 * nt + fr;
                    const float r1 = bf1(sg[200]), r0 = bf1(sg[0]), k1 = bf1(sg[200 + 64]), k0 = bf1(sg[64]), v1 = bf1(sg[200 + 128]), v0 = bf1(sg[128]);
                    const float r_ = r1 + CST(7, nt) * (r0 - r1), kx_ = k1 + CST(8, nt) * (k0 - k1), v_ = v1 + CST(9, nt) * (v0 - v1);
                    rl[nt][j] = r_; vv[nt][j] = v_; kx[nt][j] = kx_; const float kkv = kx_ * CST(2, nt); n2[j] += kkv * kkv;
                    bo[j] += r_ * kx_ * (1.f + (asg[nt][j] - 1.f) * CST(3, nt)) * CST(4, nt); if (j == 3) __builtin_amdgcn_sched_barrier(0); }
            float inv[4];
#pragma unroll
            for (int j = 0; j < 4; ++j) { inv[j] = 1.f / fmaxf(__builtin_sqrtf(red16(n2[j])), 1e-12f); bonus[j] = red16(bo[j]); }
            LDS_WAIT(); asm volatile("" ::: "memory");
            __builtin_amdgcn_sched_barrier(0);
            LAS unsigned short* AR = (LAS unsigned short*)(myslot + O_AR); LAS unsigned short* BK = (LAS unsigned short*)(myslot + O_BKY);
#pragma unroll
            for (int nt = 0; nt < 4; ++nt) { float pf[4]; pf[0] = wd[nt][0]; pf[1] = pf[0] * wd[nt][1]; pf[2] = pf[1] * wd[nt][2]; pf[3] = pf[2] * wd[nt][3];
                const float s0 = __shfl(pf[3], fr), s1 = __shfl(pf[3], fr + 16), s2 = __shfl(pf[3], fr + 32), s3 = __shfl(pf[3], fr + 48);
                const float offs = fq == 0 ? 1.f : fq == 1 ? s0 : fq == 2 ? s0 * s1 : s0 * s1 * s2, WC = (s0 * s1) * (s2 * s3);
                const float ckk = CST(2, nt), cka = CST(3, nt);
                float btv[4], ktv[4];
#pragma unroll
                for (int j = 0; j < 4; ++j) { const float W = offs * pf[j], Wm1 = j == 0 ? offs : offs * pf[j - 1], iW = __builtin_amdgcn_rcpf(W);
                    const float kkn = kx[nt][j] * ckk * inv[j], a_ = asg[nt][j], k2v = kx[nt][j] * (1.f + (a_ - 1.f) * cka);
                    const float ah = -kkn * Wm1, rh = rl[nt][j] * W, bhv = kkn * a_ * iW, khv = k2v * iW; btv[j] = bhv * WC; ktv[j] = khv * WC;
                    const int ix = (4 * fq + j) * 72 + 16 * nt + fr;
                    AR[ix] = (unsigned short)f2bf(ah); AR[16 * 72 + ix] = (unsigned short)f2bf(rh); BK[ix] = (unsigned short)f2bf(bhv); BK[16 * 72 + ix] = (unsigned short)f2bf(khv); }
                *(LAS v4u*)(myslot + O_BTK + (nt * 64 + lane) * 16) = (v4u){pk2r(btv[0], btv[1]), pk2r(btv[2], btv[3]), pk2r(ktv[0], ktv[1]), pk2r(ktv[2], ktv[3])};
                *(LAS v2u*)(myslot + O_VF + (nt * 64 + lane) * 8) = (v2u){pk2r(vv[nt][0], vv[nt][1]), pk2r(vv[nt][2], vv[nt][3])};
                if (fq == 0) ((LAS float*)(myslot + O_WC))[16 * nt + fr] = WC;
                __builtin_amdgcn_sched_barrier(0); }
            LDS_WAIT(); asm volatile("" ::: "memory");
            bf16x8 fa0[2], fa1[2], fb0[2], fb1[2];
#pragma unroll
            for (int s = 0; s < 2; ++s) { fa0[s] = *(const LAS bf16x8*)(myslot + O_AR + (fr * 72 + 32 * s + 8 * fq) * 2); fa1[s] = *(const LAS bf16x8*)(myslot + O_AR + ((16 + fr) * 72 + 32 * s + 8 * fq) * 2);
                fb0[s] = *(const LAS bf16x8*)(myslot + O_BKY + (fr * 72 + 32 * s + 8 * fq) * 2); fb1[s] = *(const LAS bf16x8*)(myslot + O_BKY + ((16 + fr) * 72 + 32 * s + 8 * fq) * 2); }
            const f4 z4 = {0.f, 0.f, 0.f, 0.f};
            f4 Lab = MFMA16(fa0[1], fb0[1], MFMA16(fa0[0], fb0[0], z4)), Lak = MFMA16(fa0[1], fb1[1], MFMA16(fa0[0], fb1[0], z4));
            f4 Lt = MFMA16(fb0[1], fa0[1], MFMA16(fb0[0], fa0[0], z4)), MrbT = MFMA16(fb0[1], fa1[1], MFMA16(fb0[0], fa1[0], z4)), MrkT = MFMA16(fb1[1], fa1[1], MFMA16(fb1[0], fa1[0], z4));
#pragma unroll
            for (int j = 0; j < 4; ++j) { const int ri = 4 * fq + j; Lab[j] = ri > fr ? Lab[j] : 0.f; Lak[j] = ri > fr ? Lak[j] : 0.f; Lt[j] = fr > ri ? Lt[j] : 0.f; MrbT[j] = fr >= ri ? MrbT[j] : 0.f; MrkT[j] = fr >= ri ? MrkT[j] : 0.f; }
            __builtin_amdgcn_sched_barrier(0);
            const bf16x8 oL = op4(Lab), oLt = op4(Lt);
            const f4 L2t = MFMA16(oLt, oL, z4), Lt2 = MFMA16(oL, oLt, z4);
            const bf16x8 oL2 = op4(L2t), oLt2 = op4(Lt2);
            const f4 L4t = MFMA16(oLt2, oL2, z4), Lt4 = MFMA16(oL2, oLt2, z4);
            const bf16x8 oL4 = op4(L4t);
            const f4 L8t = MFMA16(op4(Lt4), oL4, z4);
            f4 X = Lt;
#pragma unroll
            for (int j = 0; j < 4; ++j) X[j] += (4 * fq + j == fr) ? 1.f : 0.f;
            X = MFMA16(oL2, op4(X), X); X = MFMA16(oL4, op4(X), X); X = MFMA16(op4(L8t), op4(X), X);
            const f4 TLt = MFMA16(op4(Lak), op4(X), z4);
            *(LAS bf16x8*)(myslot + O_A2 + lane * 16) = op44(X, TLt);
            *(LAS bf16x8*)(myslot + O_M2 + lane * 16) = op44(MrbT, MrkT);
        }
        LDS_WAIT();
        __syncthreads();
        if (wv < 4) {
#pragma unroll 1
            for (int sl = 0; sl < 8; ++sl) { const LAS unsigned char* sb = L + sl * SLOT;
                const bf16x8 b1a = op44(St[0], St[1]), b1b = op44(St[2], St[3]);
                f4 Pt = {0.f, 0.f, 0.f, 0.f}, Pb = Pt;
#pragma unroll
                for (int s = 0; s < 2; ++s) { const v2u l0 = *(const LAS v2u*)(sb + O_AR + (fr * 72 + 32 * s + 4 * fq) * 2), h0 = *(const LAS v2u*)(sb + O_AR + (fr * 72 + 32 * s + 16 + 4 * fq) * 2);
                    const v2u l1 = *(const LAS v2u*)(sb + O_AR + ((16 + fr) * 72 + 32 * s + 4 * fq) * 2), h1 = *(const LAS v2u*)(sb + O_AR + ((16 + fr) * 72 + 32 * s + 16 + 4 * fq) * 2);
                    Pt = MFMA16(mk8(l0.x, l0.y, h0.x, h0.y), s ? b1b : b1a, Pt); Pb = MFMA16(mk8(l1.x, l1.y, h1.x, h1.y), s ? b1b : b1a, Pb); }
                const v2u vf = *(const LAS v2u*)(sb + O_VF + (wv * 64 + lane) * 8);
                const f4 U = MFMA16(*(const LAS bf16x8*)(sb + O_A2 + lane * 16), mk8(pk2r(Pt[0], Pt[1]), pk2r(Pt[2], Pt[3]), vf.x, vf.y), ((f4){0.f, 0.f, 0.f, 0.f}));
                const bf16x8 b3 = mk8(pk2r(U[0], U[1]), pk2r(U[2], U[3]), vf.x, vf.y);
                const f4 Yt = MFMA16(*(const LAS bf16x8*)(sb + O_M2 + lane * 16), b3, Pb);
#pragma unroll
                for (int t = 0; t < 4; ++t) { const f4 dec = *(const LAS f4*)(sb + O_WC + (16 * t + 4 * fq) * 4); St[t] = MFMA16(*(const LAS bf16x8*)(sb + O_BTK + (t * 64 + lane) * 16), b3, St[t] * dec); }
#pragma unroll
                for (int j = 0; j < 4; ++j) ((LAS float*)(sb + O_BKY))[(4 * fq + j) * 64 + 16 * wv + fr] = Yt[j];
            }
        }
        LDS_WAIT();
        __syncthreads();
        { const LAS float* Yl = (const LAS float*)(myslot + O_BKY) + (4 * fq) * 64 + fr; float mean[4], rs[4];
#pragma unroll
          for (int j = 0; j < 4; ++j) { const float s_ = (Yl[j * 64] + Yl[j * 64 + 16]) + (Yl[j * 64 + 32] + Yl[j * 64 + 48]); mean[j] = red16(s_) * (1.f / 64.f); }
#pragma unroll
          for (int j = 0; j < 4; ++j) { const float d0 = Yl[j * 64] - mean[j], d1 = Yl[j * 64 + 16] - mean[j], d2 = Yl[j * 64 + 32] - mean[j], d3 = Yl[j * 64 + 48] - mean[j];
              rs[j] = __builtin_amdgcn_rsqf(red16((d0 * d0 + d1 * d1) + (d2 * d2 + d3 * d3)) * (1.f / 64.f) + GN_EPS); }
          __builtin_amdgcn_sched_barrier(0);
#pragma unroll
          for (int nt = 0; nt < 4; ++nt) { const v2u vf = *(const LAS v2u*)(myslot + O_VF + (nt * 64 + lane) * 8); const float lw = CST(5, nt), lb = CST(6, nt);
              const float v4_[4] = {bf_lo(vf.x), bf_hi(vf.x), bf_lo(vf.y), bf_hi(vf.y)}, g4_[4] = {bf_lo(ggp[nt][0]), bf_hi(ggp[nt][0]), bf_lo(ggp[nt][1]), bf_hi(ggp[nt][1])};
#pragma unroll
              for (int j = 0; j < 4; ++j) { const float o = ((Yl[j * 64 + 16 * nt] - mean[j]) * rs[j] * lw + lb + bonus[j] * v4_[j]) * g4_[j];
                  if (!dry) *(GAS unsigned short*)(bO + ((unsigned)(t0 + 4 * fq + j) * 2048u + (16 * nt + fr) * 2u)) = (unsigned short)f2bf(o); }
              __builtin_amdgcn_sched_barrier(0); } }
        if (rnd + 1 < SEQ / 128) RW_LOAD_LZ(t0 + 128);
    }
#undef RW_LOAD_LZ
#undef RW_LOAD_RKV
#undef CST
}

__device__ __forceinline__ void hgrn_phase(Frame& F, int bh, bool dry) {
    const int b = bh >> 3, h = bh & 7, tid = F.tid, lane = F.lane, w = F.wave, fr = lane & 15, fq = lane >> 4;
    LAS unsigned char* L = F.lds;
    constexpr int QIN = 0, KIN = 8704, QDEC = 17408, KDT = 26112, VT = 36352, SCM = 46592, SB = 49152, OBUF = 83968, SEG = 100864, DEC = 102912;
    const bf16* Qg = (const bf16*)(F.ws + WS_Q); const bf16* KFg = (const bf16*)(F.ws + WS_KF); const bf16* HGg = (const bf16*)(F.ws + WS_HG); bf16* VIg = (bf16*)(F.ws + WS_VI);
    const float* gn = F.in[4];
    const int k = tid & 127, q = tid >> 7;
    const size_t rowbase = (size_t)b * SEQ; const int colb = h * 128;
    for (int u = tid; u < 34816 / 16; u += 512) *(LAS v4u*)(L + SB + u * 16) = (v4u){0u, 0u, 0u, 0u};
    pg8::f32x4 Sacc[8];
#pragma unroll
    for (int t = 0; t < 8; ++t) Sacc[t] = (pg8::f32x4){0.f, 0.f, 0.f, 0.f};
    unsigned short pq[8], pk[8], pv[8];
#define HGRN_PREFETCH(T0) do { _Pragma("unroll") for (int j = 0; j < 8; ++j) { const size_t off = (rowbase + (T0) + 8 * q + j) * D + colb + k; pq[j] = Qg[off]; pk[j] = KFg[off]; pv[j] = VIg[off]; } } while (0)
    HGRN_PREFETCH(0);
    const float g0 = gn[colb + lane], g1 = gn[colb + 64 + lane];
    __syncthreads();
    for (int c = 0; c < SEQ / 32; ++c) {
        const int t0 = 32 * c;
        float qf[8], kf[8], pl[8];
        { float run = 0.f;
#pragma unroll
          for (int j = 0; j < 8; ++j) { qf[j] = bf1(pq[j]); kf[j] = h1(pk[j]); run += __logf(1.f - kf[j]); pl[j] = run; }
          ((LAS float*)(L + SEG))[q * 128 + k] = run;
          v4u o; o.x = (unsigned)pv[0] | ((unsigned)pv[1] << 16); o.y = (unsigned)pv[2] | ((unsigned)pv[3] << 16); o.z = (unsigned)pv[4] | ((unsigned)pv[5] << 16); o.w = (unsigned)pv[6] | ((unsigned)pv[7] << 16);
          *(LAS v4u*)(L + VT + (k * 40 + 8 * q) * 2) = o; }
        __syncthreads();
        if (c + 1 < SEQ / 32) HGRN_PREFETCH(t0 + 32);
        { const LAS float* seg = (const LAS float*)(L + SEG);
          const float s0 = seg[k], s1 = seg[128 + k], s2 = seg[256 + k], s3 = seg[384 + k];
          const float offs = q == 0 ? 0.f : q == 1 ? s0 : q == 2 ? s0 + s1 : s0 + s1 + s2;
          const float bref = s0 + s1, blast = (s0 + s1) + (s2 + s3);
          const float Elr = __expf(blast - bref), Eref = __expf(bref);
          if (q == 3) ((LAS float*)(L + DEC))[k] = Elr * Eref;
          unsigned short kd[8];
#pragma unroll
          for (int j = 0; j < 8; ++j) { const float bj = offs + pl[j]; const float e1 = __expf(bj - bref), r1 = __builtin_amdgcn_rcpf(e1); const int i = 8 * q + j;
              *(LAS unsigned short*)(L + QIN + (i * 136 + k) * 2) = (unsigned short)f2bf(qf[j] * e1);
              *(LAS unsigned short*)(L + KIN + (i * 136 + k) * 2) = (unsigned short)f2bf(kf[j] * r1);
              *(LAS unsigned short*)(L + QDEC + (i * 136 + k) * 2) = (unsigned short)f2bf(qf[j] * e1 * Eref);
              kd[j] = (unsigned short)f2bf(kf[j] * Elr * r1); }
          v4u o; o.x = (unsigned)kd[0] | ((unsigned)kd[1] << 16); o.y = (unsigned)kd[2] | ((unsigned)kd[3] << 16); o.z = (unsigned)kd[4] | ((unsigned)kd[5] << 16); o.w = (unsigned)kd[6] | ((unsigned)kd[7] << 16);
          *(LAS v4u*)(L + KDT + (k * 40 + 8 * q) * 2) = o; }
        __syncthreads();
        pg8::f32x4 oacc[2];
#pragma unroll
        for (int t = 0; t < 2; ++t) { const int tile = 2 * w + t, ti = tile >> 3, tv = tile & 7; pg8::f32x4 a = {0.f, 0.f, 0.f, 0.f};
#pragma unroll
            for (int ks = 0; ks < 4; ++ks) { const bf16x8 af = *(const LAS bf16x8*)(L + QDEC + ((16 * ti + fr) * 136 + ks * 32 + 8 * fq) * 2); const bf16x8 bfm = *(const LAS bf16x8*)(L + SB + ((16 * tv + fr) * 136 + ks * 32 + 8 * fq) * 2);
                a = __builtin_amdgcn_mfma_f32_16x16x32_bf16(af, bfm, a, 0, 0, 0); }
            oacc[t] = a; }
        if (w < 4) { const int ti = w >> 1, tj = w & 1; pg8::f32x4 a = {0.f, 0.f, 0.f, 0.f};
            if (tj <= ti) {
#pragma unroll
                for (int ks = 0; ks < 4; ++ks) { const bf16x8 af = *(const LAS bf16x8*)(L + QIN + ((16 * ti + fr) * 136 + ks * 32 + 8 * fq) * 2); const bf16x8 bfm = *(const LAS bf16x8*)(L + KIN + ((16 * tj + fr) * 136 + ks * 32 + 8 * fq) * 2);
                    a = __builtin_amdgcn_mfma_f32_16x16x32_bf16(af, bfm, a, 0, 0, 0); } }
#pragma unroll
            for (int j = 0; j < 4; ++j) { const int i = 16 * ti + 4 * fq + j, jj = 16 * tj + fr; const float s = (jj <= i) ? a[j] : 0.f; *(LAS unsigned short*)(L + SCM + (i * 40 + jj) * 2) = (unsigned short)f2bf(s); } }
        __syncthreads();
        { bf16x8 vfr[8];
#pragma unroll
          for (int tv = 0; tv < 8; ++tv) vfr[tv] = *(const LAS bf16x8*)(L + VT + ((16 * tv + fr) * 40 + 8 * fq) * 2);
#pragma unroll
          for (int t = 0; t < 2; ++t) { const int tile = 2 * w + t, ti = tile >> 3, tv = tile & 7;
              const bf16x8 af = *(const LAS bf16x8*)(L + SCM + ((16 * ti + fr) * 40 + 8 * fq) * 2);
              const bf16x8 bfm = *(const LAS bf16x8*)(L + VT + ((16 * tv + fr) * 40 + 8 * fq) * 2);
              oacc[t] = __builtin_amdgcn_mfma_f32_16x16x32_bf16(af, bfm, oacc[t], 0, 0, 0);
#pragma unroll
              for (int j = 0; j < 4; ++j) ((LAS float*)(L + OBUF))[(16 * ti + 4 * fq + j) * 132 + 16 * tv + fr] = oacc[t][j]; }
          const pg8::f32x4 d4 = *(const LAS pg8::f32x4*)(L + DEC + (16 * w + 4 * fq) * 4);
          const bf16x8 kfrag = *(const LAS bf16x8*)(L + KDT + ((16 * w + fr) * 40 + 8 * fq) * 2);
#pragma unroll
          for (int tv = 0; tv < 8; ++tv) { pg8::f32x4 s = Sacc[tv] * d4; s = __builtin_amdgcn_mfma_f32_16x16x32_bf16(kfrag, vfr[tv], s, 0, 0, 0); Sacc[tv] = s;
              v2u o; o.x = pk2(s[0], s[1]); o.y = pk2(s[2], s[3]); *(LAS v2u*)(L + SB + ((16 * tv + fr) * 136 + 16 * w + 4 * fq) * 2) = o; } }
        __syncthreads();
        { const LAS float* ob = (const LAS float*)(L + OBUF);
#pragma unroll
          for (int jj = 0; jj < 4; ++jj) { const int i = 4 * w + jj; const float o0 = ob[i * 132 + lane], o1 = ob[i * 132 + 64 + lane];
              const float rstd = __builtin_amdgcn_rsqf(wave_sum(o0 * o0 + o1 * o1) * (1.f / 128.f) + EPS);
              const size_t off = (rowbase + t0 + i) * D + colb + lane;
              if (!dry) { VIg[off] = (bf16)f2bf(o0 * rstd * g0 * bf1(HGg[off])); VIg[off + 64] = (bf16)f2bf(o1 * rstd * g1 * bf1(HGg[off + 64])); } } }
    }
}

__device__ __forceinline__ void p5_rows(Frame& F) {
    const int gw = F.bid * NWAVES + F.wave, NGW = F.G * NWAVES, lane = F.lane;
    const float* MIX = (const float*)(F.ws + WS_MIX); const float* SSP = (const float*)(F.ws + WS_SS1); bf16* HB = (bf16*)(F.ws + WS_HB);
    const GAS f32x4* g1 = (const GAS f32x4*)F.in[19] + lane; const GAS f32x4* g2 = (const GAS f32x4*)F.in[20] + lane;
    for (int m = gw; m < M; m += NGW) {
        const float sp = lane < 16 ? SSP[(size_t)m * 16 + lane] : 0.f;
        const float rstd1 = __builtin_amdgcn_rsqf(wave_sum(sp) * (1.f / D) + EPS);
        const GAS f32x4* mr = (const GAS f32x4*)(MIX + (size_t)m * D) + lane; const GAS f32x4* xr = (const GAS f32x4*)(F.in[0] + (size_t)m * D) + lane; GAS f32x4* hr = (GAS f32x4*)(F.out + (size_t)m * D) + lane;
        f32x4 hv[4]; float s = 0.f;
#pragma unroll
        for (int j = 0; j < 4; ++j) { hv[j] = xr[64 * j] + mr[64 * j] * rstd1 * g1[64 * j]; hr[64 * j] = hv[j]; s += (hv[j].x * hv[j].x + hv[j].y * hv[j].y) + (hv[j].z * hv[j].z + hv[j].w * hv[j].w); }
        const float rstd2 = __builtin_amdgcn_rsqf(wave_sum(s) * (1.f / D) + EPS);
        GAS unsigned long long* o8 = (GAS unsigned long long*)(HB + (size_t)m * D) + lane;
#pragma unroll
        for (int j = 0; j < 4; ++j) { const f32x4 gg = g2[64 * j]; o8[64 * j] = (unsigned long long)pk2(hv[j].x * rstd2 * gg.x, hv[j].y * rstd2 * gg.y) | ((unsigned long long)pk2(hv[j].z * rstd2 * gg.z, hv[j].w * rstd2 * gg.w) << 32); }
    }
}
__device__ __forceinline__ void p11_rows(Frame& F) {
    const int gw = F.bid * NWAVES + F.wave, NGW = F.G * NWAVES, lane = F.lane;
    const float* FFo = (const float*)(F.ws + WS_MIX); const float* SSP = (const float*)(F.ws + WS_SS3);
    const GAS f32x4* g3 = (const GAS f32x4*)F.in[25] + lane;
    for (int m = gw; m < M; m += NGW) {
        const float sp = lane < 16 ? SSP[(size_t)m * 16 + lane] : 0.f;
        const float rstd = __builtin_amdgcn_rsqf(wave_sum(sp) * (1.f / D) + EPS);
        const GAS f32x4* fr = (const GAS f32x4*)(FFo + (size_t)m * D) + lane; GAS f32x4* hr = (GAS f32x4*)(F.out + (size_t)m * D) + lane;
#pragma unroll
        for (int j = 0; j < 4; ++j) hr[64 * j] = hr[64 * j] + fr[64 * j] * rstd * g3[64 * j];
    }
}
__device__ __forceinline__ void conv_phase(Frame& F, int half) {
    const bf16* HU = (const bf16*)(F.ws + WS_HU); bf16* ACT = (bf16*)(F.ws + WS_ACT);
    const float* cw = F.in[22]; const float* cb = F.in[23];
    constexpr int NCG = DFF / 8, NRR = MH / 32, NT = NCG * NRR;
    for (int task = F.bid * 512 + F.tid; task < NT; task += F.G * 512) {
        const int cgi = task % NCG, rr = task / NCG, c = 8 * cgi, r0 = 32 * rr;
        float wg[3][8], wv[3][8], bg[8], bv[8];
#pragma unroll
        for (int e = 0; e < 8; ++e) { bg[e] = cb[c + e]; bv[e] = cb[DFF + c + e];
#pragma unroll
            for (int j = 0; j < 3; ++j) { wg[j][e] = cw[j * NUP + c + e]; wv[j][e] = cw[j * NUP + DFF + c + e]; } }
        float g1[8], g2[8], v1[8], v2[8];
        const bool seq_start = (r0 % SEQ) == 0;
        auto unpack = [](v4u u, float* o) { o[0] = bf_lo(u.x); o[1] = bf_hi(u.x); o[2] = bf_lo(u.y); o[3] = bf_hi(u.y); o[4] = bf_lo(u.z); o[5] = bf_hi(u.z); o[6] = bf_lo(u.w); o[7] = bf_hi(u.w); };
        if (seq_start) {
#pragma unroll
            for (int e = 0; e < 8; ++e) { g1[e] = g2[e] = v1[e] = v2[e] = 0.f; }
        } else { unpack(*(const GAS v4u*)(HU + (size_t)(r0 - 1) * NUP + c), g1); unpack(*(const GAS v4u*)(HU + (size_t)(r0 - 2) * NUP + c), g2);
                 unpack(*(const GAS v4u*)(HU + (size_t)(r0 - 1) * NUP + DFF + c), v1); unpack(*(const GAS v4u*)(HU + (size_t)(r0 - 2) * NUP + DFF + c), v2); }
#pragma unroll 4
        for (int i = 0; i < 32; ++i) { float g0[8], v0[8]; unpack(*(const GAS v4u*)(HU + (size_t)(r0 + i) * NUP + c), g0); unpack(*(const GAS v4u*)(HU + (size_t)(r0 + i) * NUP + DFF + c), v0);
            float o[8];
#pragma unroll
            for (int e = 0; e < 8; ++e) { const float gt = bg[e] + wg[0][e] * g2[e] + wg[1][e] * g1[e] + wg[2][e] * g0[e]; const float vl = bv[e] + wv[0][e] * v2[e] + wv[1][e] * v1[e] + wv[2][e] * v0[e];
                o[e] = gt * fsig(gt) * vl; g2[e] = g1[e]; g1[e] = g0[e]; v2[e] = v1[e]; v1[e] = v0[e]; }
            v4u w; w.x = pk2(o[0], o[1]); w.y = pk2(o[2], o[3]); w.z = pk2(o[4], o[5]); w.w = pk2(o[6], o[7]);
            *(GAS v4u*)(ACT + (size_t)(half * MH + r0 + i) * DFF + c) = w; }
    }
}

struct Args { const float* in[26]; float* out; unsigned char* ws; int ph_lo, ph_hi; };
__global__ void __launch_bounds__(NWAVES * 64, 2) fwd_kernel(Args args) {
    extern __shared__ __attribute__((aligned(16))) unsigned char lds[];
    Frame F;
    F.lds = (LAS unsigned char*)lds; F.tid = threadIdx.x; F.lane = F.tid & 63; F.wave = __builtin_amdgcn_readfirstlane(F.tid >> 6); F.G = gridDim.x; F.bid = blockIdx.x;
#pragma unroll
    for (int i = 0; i < 26; ++i) F.in[i] = args.in[i];
    F.out = args.out; F.ws = args.ws;
    const int lo = args.ph_lo, hi = args.ph_hi;
    if (F.tid < 16) ((LAS unsigned*)(F.lds + MISC_OFF))[F.tid] = 0u;
    __syncthreads();
    XcdBarrier gbar; gbar.bar = (unsigned*)(args.ws + WS_CTL) + CW_BAR; gbar.x = 0; gbar.st = nullptr;
    if (hi - lo > 1) gbar = xcd_barrier_post((unsigned*)(args.ws + WS_CTL) + CW_BAR, (volatile LAS unsigned*)(F.lds + MISC_OFF));
    if (lo > 1000) cg::this_grid().sync();
#ifndef REP_MASK
#define REP_MASK 0
#endif
#define NREP(k) (1 + ((REP_MASK >> (k)) & 1))
#ifndef DIAG_SCAN
#define DIAG_SCAN 3
#endif
#ifndef DIAG_MASK
#define DIAG_MASK 0xFFF
#endif
#define IN(k) (((DIAG_MASK >> (k)) & 1) && lo <= (k) && (k) < hi)
#define SEAM(k) do { if (IN(k) && IN((k) + 1)) { xcd_barrier(gbar); } } while (0)
    unsigned char* ws = args.ws; unsigned char* ob = (unsigned char*)args.out;
    if (IN(0)) { _Pragma("unroll 1") for (int rep = 0; rep < NREP(0); ++rep) p0_prologue(F); } SEAM(0);
    if (IN(1)) {
        pg8::Gemm g{(const pg8::bf16_t*)(ob + OUT_XN), (const pg8::bf16_t*)(ws + WS_W1), M, N1, D}; pg8::StaticOrder S; S.init(M, N1, F.G, F.bid);
        pg8::EpiG1 E{(bf16*)(ws + WS_Q), (bf16*)(ws + WS_KF), (bf16*)(ws + WS_VI), (bf16*)(ws + WS_HG), (bf16*)(ws + WS_R), (bf16*)(ws + WS_K), (bf16*)(ob + OUT_V), (bf16*)(ws + WS_LZ), F.in[3]};
        _Pragma("unroll 1") for (int rep = 0; rep < NREP(1); ++rep) { pg8::gemm_phase<pg8::EpiG1, pg8::StaticOrder, true, true>(F.lds, g, S, E); __syncthreads(); }
    } SEAM(1);
    if (IN(2)) {
        if (F.bid < 128) { _Pragma("unroll 1") for (int rep = 0; rep < NREP(2); ++rep) { rwkv_phase(F, F.bid, rep + 1 < NREP(2)); __syncthreads(); } } else if (F.bid < 192) { _Pragma("unroll 1") for (int rep = 0; rep < NREP(12); ++rep) { hgrn_phase(F, F.bid - 128, rep + 1 < NREP(12)); __syncthreads(); } }
    } SEAM(2);
    if (IN(3)) {
        pg8::Gemm g{(const pg8::bf16_t*)(ob + OUT_XN), (const pg8::bf16_t*)(ws + WS_W3), M, 4096, D};
        pg8::OrderG3 S; S.init(M, D, F.G, F.bid); S.a_xn = (const pg8::bf16_t*)(ob + OUT_XN); S.a_oa = (const pg8::bf16_t*)(ws + WS_VI); S.a_ob = (const pg8::bf16_t*)(ob + OUT_V);
        pg8::EpiG3 E{(pg8::f32x4*)(ws + WS_SCR) + (size_t)F.bid * (2 * 32 * 512), (bf16*)(ws + WS_MRG)};
        _Pragma("unroll 1") for (int rep = 0; rep < NREP(3); ++rep) { pg8::gemm_phase<pg8::EpiG3, pg8::OrderG3, false, true>(F.lds, g, S, E); __syncthreads(); }
    } SEAM(3);
    if (IN(4)) {
        pg8::Gemm g{(const pg8::bf16_t*)(ws + WS_MRG), (const pg8::bf16_t*)(ws + WS_WOUT), M, D, D}; pg8::StaticOrder S; S.init(M, D, F.G, F.bid);
        pg8::EpiF32SS E{(float*)(ws + WS_MIX), (float*)(ws + WS_SS1), D};
        _Pragma("unroll 1") for (int rep = 0; rep < NREP(4); ++rep) { pg8::gemm_phase<pg8::EpiF32SS, pg8::StaticOrder, false, true>(F.lds, g, S, E); __syncthreads(); }
    } SEAM(4);
    if (IN(5)) { _Pragma("unroll 1") for (int rep = 0; rep < NREP(5); ++rep) p5_rows(F); } SEAM(5);
#pragma unroll 1
    for (int half = 0; half < 2; ++half) {
        if (IN(6 + 2 * half)) {
            pg8::Gemm g{(const pg8::bf16_t*)(ws + WS_HB) + (size_t)half * MH * D, (const pg8::bf16_t*)(ws + WS_WUP), MH, NUP, D}; pg8::StaticOrder S; S.init(MH, NUP, F.G, F.bid);
            pg8::EpiBf16Raw E{(bf16*)(ws + WS_HU), NUP};
            _Pragma("unroll 1") for (int rep = 0; rep < NREP(6); ++rep) { pg8::gemm_phase<pg8::EpiBf16Raw, pg8::StaticOrder, true, true>(F.lds, g, S, E); __syncthreads(); }
        } SEAM(6 + 2 * half);
        if (IN(7 + 2 * half)) { _Pragma("unroll 1") for (int rep = 0; rep < NREP(7); ++rep) conv_phase(F, half); } SEAM(7 + 2 * half);
    }
    if (IN(10)) {
        pg8::Gemm g{(const pg8::bf16_t*)(ws + WS_ACT), (const pg8::bf16_t*)(ws + WS_WDN), M, D, DFF}; pg8::StaticOrder S; S.init(M, D, F.G, F.bid);
        pg8::EpiF32SS E{(float*)(ws + WS_MIX), (float*)(ws + WS_SS3), D};
        _Pragma("unroll 1") for (int rep = 0; rep < NREP(10); ++rep) { pg8::gemm_phase<pg8::EpiF32SS, pg8::StaticOrder, false, true>(F.lds, g, S, E); __syncthreads(); }
    } SEAM(10);
    if (IN(11)) { p11_rows(F); }
#undef IN
#undef SEAM
}

extern "C" void kernel_launch(void* const* d_in, const int* in_sizes, int n_in, void* d_out, int out_size, void* d_ws, size_t ws_size, hipStream_t stream) {
    static int grid = 0;
    if (grid == 0) {
        if (n_in != 26 || in_sizes[0] != M * D || out_size != M * D || ws_size < WS_END) { fprintf(stderr, "kernel_launch: unexpected shapes (n_in %d, in0 %d, out %d, ws %zu); nothing launched\n", n_in, n_in > 0 ? in_sizes[0] : -1, out_size, ws_size); grid = -1; return; }
        int dev = 0, cus = 0, per_cu = 0;
        if (hipGetDevice(&dev) != hipSuccess || hipDeviceGetAttribute(&cus, hipDeviceAttributeMultiprocessorCount, dev) != hipSuccess) { grid = -1; return; }
        if (hipFuncSetAttribute((const void*)fwd_kernel, hipFuncAttributeMaxDynamicSharedMemorySize, LDS_BYTES) != hipSuccess) { fprintf(stderr, "kernel_launch: hipFuncSetAttribute failed\n"); grid = -1; return; }
        if (hipOccupancyMaxActiveBlocksPerMultiprocessor(&per_cu, (const void*)fwd_kernel, NWAVES * 64, LDS_BYTES) != hipSuccess || per_cu < 1) { fprintf(stderr, "kernel_launch: occupancy query reports %d blocks per CU\n", per_cu); per_cu = 1; }
        (void)hipGetLastError();
        grid = cus;
    }
    if (grid < 0) return;
    Args a{};
    for (int i = 0; i < 26; ++i) a.in[i] = (const float*)d_in[i];
    a.out = (float*)d_out; a.ws = (unsigned char*)d_ws;
#if MK_ONE_LAUNCH
    a.ph_lo = 0; a.ph_hi = N_PHASES;
    if (hipMemsetAsync((char*)d_ws + WS_CTL, 0, 65536, stream) != hipSuccess) { fprintf(stderr, "kernel_launch: hipMemsetAsync failed\n"); return; }
    void* kargs[] = {&a};
    hipError_t e = hipLaunchCooperativeKernel((const void*)fwd_kernel, dim3(grid), dim3(NWAVES * 64), kargs, LDS_BYTES, stream);
    if (e != hipSuccess) fprintf(stderr, "kernel_launch: cooperative launch failed: %s (grid %d)\n", hipGetErrorString(e), grid);
#else
    for (int ph = 0; ph < N_PHASES; ++ph) {
        a.ph_lo = ph; a.ph_hi = ph + 1;
        hipLaunchKernelGGL(fwd_kernel, dim3(grid), dim3(NWAVES * 64), LDS_BYTES, stream, a);
        const hipError_t le = hipPeekAtLastError();
        if (le != hipSuccess) { fprintf(stderr, "kernel_launch: launch %d failed: %s\n", ph, hipGetErrorName(le)); break; }
    }
#endif
}
```

```cpp
#include <hip/hip_runtime.h>
#include <hip/hip_cooperative_groups.h>
#include <cstdio>
#include <cstdint>
namespace cg = cooperative_groups;

__device__ __forceinline__ int hw_lane() { int l_; asm volatile("v_mbcnt_lo_u32_b32 %0, -1, 0\n\tv_mbcnt_hi_u32_b32 %0, -1, %0" : "=v"(l_)); return l_; }
namespace pg8 {
#define PG8_LAS __attribute__((address_space(3)))
typedef unsigned short bf16_t;
typedef short bf16x8 __attribute__((ext_vector_type(8)));
typedef float f32x4 __attribute__((ext_vector_type(4)));
typedef float f32x2 __attribute__((ext_vector_type(2)));
typedef unsigned u32x4 __attribute__((ext_vector_type(4)));
typedef _Float16 h16x2 __attribute__((ext_vector_type(2)));
constexpr int BM = 256, BK = 64, HALF = 128, HTB = HALF * BK * 2  , STAGE_BYTES = 8 * HTB, NXCD = 8, WGM = 8;

__host__ __device__ __forceinline__ int lds_byte(int r, int c) { const int st = (r >> 4) * 2 + (c >> 5), rr = r & 15, cc = c & 31, ob = rr * 64 + cc * 2; return st * 1024 + (ob ^ (((ob >> 9) & 1) << 5)); }
__host__ __device__ __forceinline__ void stage_rc(int b, int& R, int& C) { const int st = b / 1024, sb = b % 1024, swz = sb ^ (((sb >> 9) & 1) << 5); R = (st >> 1) * 16 + swz / 64; C = (st & 1) * 32 + (swz % 64) / 2; }
__host__ __device__ __forceinline__ int perm32(int rho) { const int n = rho >> 4, i = rho & 15; return 8 * (i >> 2) + 4 * n + (i & 3); }

struct Unit { int pm, pn; };
struct Gemm { const bf16_t* A; const bf16_t* Bt; int M, N, K; };

struct StaticOrder {
    int nM, nN, nwg, G, c;
    __host__ __device__ void init(int M, int N, int G_, int c_) { nM = M / BM; nN = N / BM; nwg = nM * nN; G = G_; c = c_; }
    __host__ __device__ __forceinline__ bool next(int i, Unit& u) const {
        const long L = (long)i * G + c; if (L >= nwg) return false;
        int wgid = (int)L; { const int q = nwg / NXCD, r = nwg % NXCD, xcd = wgid % NXCD, off = wgid / NXCD; wgid = (xcd < r ? xcd * (q + 1) : r * (q + 1) + (xcd - r) * q) + off; }
        const int nig = WGM * nN, gid = wgid / nig, fm = gid * WGM, gsz = (nM - fm) < WGM ? (nM - fm) : WGM;
        u.pm = fm + ((wgid % nig) % gsz); u.pn = (wgid % nig) / gsz; return true;
    }
    __device__ __forceinline__ const char* pa(const Gemm& g, const Unit& u) const { return (const char*)g.A + (size_t)u.pm * ((size_t)BM * g.K * 2); }
    __device__ __forceinline__ const char* pb(const Gemm& g, const Unit& u) const { return (const char*)g.Bt + (size_t)u.pn * ((size_t)BM * g.K * 2); }
    __device__ __forceinline__ void a_ready(const Unit&) const {}
    __device__ __forceinline__ void done(const Unit&) const {}
};
struct OrderG3 {
    int pm, pn0, valid; const bf16_t *a_xn, *a_oa, *a_ob;
    __device__ __forceinline__ void init(int M, int N, int G_, int c_) { StaticOrder b; b.init(M, N, G_, c_); Unit t; t.pm = 0; t.pn = 0; valid = b.next(0, t) ? 1 : 0; pm = t.pm; pn0 = t.pn; }
    __device__ __forceinline__ bool next(int i, Unit& u) const { if (i >= 4 || !valid) return false; u.pm = pm; u.pn = 4 * i + pn0; return true; }
    __device__ __forceinline__ const char* pa(const Gemm& g, const Unit& u) const { const int s = u.pn >> 2; const long long d1 = (const char*)a_oa - (const char*)a_xn, d3 = (const char*)a_ob - (const char*)a_xn; const long long off = (long long)(s == 1) * d1 + (long long)(s == 3) * d3; return (const char*)a_xn + off + (size_t)u.pm * ((size_t)BM * g.K * 2); }
    __device__ __forceinline__ const char* pb(const Gemm& g, const Unit& u) const { return (const char*)g.Bt + (size_t)u.pn * ((size_t)BM * g.K * 2); }
    __device__ __forceinline__ void a_ready(const Unit&) const {}
    __device__ __forceinline__ void done(const Unit&) const {}
};

typedef __bf16 bf16x2_t __attribute__((ext_vector_type(2)));
__device__ __forceinline__ unsigned cvt_pk_bf16(float lo, float hi) { const f32x2 v = {lo, hi}; return __builtin_bit_cast(unsigned, __builtin_convertvector(v, bf16x2_t)); }
__device__ __forceinline__ unsigned cvt_pk_f16(float lo, float hi) { h16x2 v; v.x = (_Float16)lo; v.y = (_Float16)hi; return __builtin_bit_cast(unsigned, v); }
__device__ __forceinline__ float fsigmoid(float x) { return __builtin_amdgcn_rcpf(1.0f + __expf(-x)); }

struct EpiG1 {
    static constexpr bool PERM = true, AFTER_DRAIN = false;
    bf16_t *Q, *KF, *VI, *HG, *R, *K, *V, *LZ; const float* lbraw;
    template <int MODE> __device__ __forceinline__ void tile(const f32x4 (&acc)[2][2][4][2], bf16_t* base, int ldc, int row0, int col0) const {
        float oml[2][8];
        if (MODE == 1) {
#pragma unroll
            for (int bj = 0; bj < 2; ++bj)
#pragma unroll
                for (int e = 0; e < 8; ++e) { const int c = col0 + bj * HALF + e; oml[bj][e] = fsigmoid(lbraw[1024 + c] - lbraw[c]); }
        }
#pragma unroll
        for (int ai = 0; ai < 2; ++ai)
#pragma unroll
            for (int m = 0; m < 4; ++m) { bf16_t* rowp = base + (size_t)(row0 + ai * HALF + m * 16) * ldc + col0;
#pragma unroll
                for (int bj = 0; bj < 2; ++bj) { float v[8];
#pragma unroll
                    for (int e = 0; e < 4; ++e) { v[e] = acc[ai][bj][m][0][e]; v[4 + e] = acc[ai][bj][m][1][e]; }
                    u32x4 w;
                    if (MODE == 0) {
#pragma unroll
                        for (int e = 0; e < 8; ++e) v[e] = v[e] * fsigmoid(v[e]) * 0.08838834764831845f;
                    } else if (MODE == 1) {
#pragma unroll
                        for (int e = 0; e < 8; ++e) v[e] = oml[bj][e] * fsigmoid(-v[e]);
                    } else if (MODE == 3) {
#pragma unroll
                        for (int e = 0; e < 8; ++e) v[e] = v[e] * fsigmoid(v[e]);
                    }
                    if (MODE == 1) { w.x = cvt_pk_f16(v[0], v[1]); w.y = cvt_pk_f16(v[2], v[3]); w.z = cvt_pk_f16(v[4], v[5]); w.w = cvt_pk_f16(v[6], v[7]); }
                    else { w.x = cvt_pk_bf16(v[0], v[1]); w.y = cvt_pk_bf16(v[2], v[3]); w.z = cvt_pk_bf16(v[4], v[5]); w.w = cvt_pk_bf16(v[6], v[7]); }
                    *(u32x4*)(rowp + bj * HALF) = w; } }
    }
    __device__ __forceinline__ void operator()(const f32x4 (&acc)[2][2][4][2], const Unit& u, int wr, int wc, int fr, int fq) const {
        const int pn = u.pn, row0 = u.pm * BM + wr * 64 + fr, cw = wc * 32 + 8 * fq;
        if (pn < 4) tile<0>(acc, Q, 1024, row0, pn * 256 + cw);
        else if (pn < 8) tile<1>(acc, KF, 1024, row0, (pn - 4) * 256 + cw);
        else if (pn < 12) tile<2>(acc, VI, 1024, row0, (pn - 8) * 256 + cw);
        else if (pn < 16) tile<3>(acc, HG, 1024, row0, (pn - 12) * 256 + cw);
        else if (pn < 20) tile<2>(acc, R, 1024, row0, (pn - 16) * 256 + cw);
        else if (pn < 24) tile<2>(acc, K, 1024, row0, (pn - 20) * 256 + cw);
        else if (pn < 28) tile<2>(acc, V, 1024, row0, (pn - 24) * 256 + cw);
        else tile<2>(acc, LZ, 256, row0, cw);
    }
};

struct EpiG3 {
    static constexpr bool PERM = true, AFTER_DRAIN = false;
    f32x4* scr;
    int wave_;
    bf16_t* O;
    __device__ __forceinline__ void operator()(const f32x4 (&acc)[2][2][4][2], const Unit& u, int wr, int wc, int fr, int fq) const {
        const int s = u.pn >> 2, pn0 = u.pn & 3, tid = wave_ * 64 + hw_lane();
        f32x4* t0 = scr + tid * 32; f32x4* t1 = scr + 32 * 512 + tid * 32;
        if (s == 0 || s == 2) { f32x4* t = s ? t1 : t0;
#pragma unroll
            for (int ai = 0; ai < 2; ++ai)
#pragma unroll
                for (int bj = 0; bj < 2; ++bj)
#pragma unroll
                    for (int m = 0; m < 4; ++m)
#pragma unroll
                        for (int n = 0; n < 2; ++n) { const f32x4 a = acc[ai][bj][m][n]; f32x4 r; r.x = fsigmoid(a.x); r.y = fsigmoid(a.y); r.z = fsigmoid(a.z); r.w = fsigmoid(a.w); t[((ai * 2 + bj) * 4 + m) * 2 + n] = r; }
        } else if (s == 1) {
#pragma unroll
            for (int ai = 0; ai < 2; ++ai)
#pragma unroll
                for (int bj = 0; bj < 2; ++bj)
#pragma unroll
                    for (int m = 0; m < 4; ++m)
                        { _Pragma("unroll") for (int n = 0; n < 2; ++n) { const int ix = ((ai * 2 + bj) * 4 + m) * 2 + n; t0[ix] = t0[ix] * acc[ai][bj][m][n]; } if (m & 1) asm volatile("" ::: "memory"); }
        } else {
            const int row0 = u.pm * BM + wr * 64 + fr, col0 = pn0 * BM + wc * 32 + 8 * fq;
#pragma unroll
            for (int ai = 0; ai < 2; ++ai)
#pragma unroll
                for (int m = 0; m < 4; ++m) { bf16_t* rowp = O + (size_t)(row0 + ai * HALF + m * 16) * 1024 + col0;
#pragma unroll
                    for (int bj = 0; bj < 2; ++bj) { const int ix = ((ai * 2 + bj) * 4 + m) * 2;
                        const f32x4 v0 = t0[ix] + t1[ix] * acc[ai][bj][m][0], v1 = t0[ix + 1] + t1[ix + 1] * acc[ai][bj][m][1];
                        u32x4 w; w.x = cvt_pk_bf16(v0[0], v0[1]); w.y = cvt_pk_bf16(v0[2], v0[3]); w.z = cvt_pk_bf16(v1[0], v1[1]); w.w = cvt_pk_bf16(v1[2], v1[3]);
                        *(u32x4*)(rowp + bj * HALF) = w; } asm volatile("" ::: "memory"); }
        }
    }
};

struct EpiF32SS {
    static constexpr bool PERM = false, AFTER_DRAIN = false;
    float* out; float* ssp; int ldc;
    __device__ __forceinline__ void operator()(const f32x4 (&acc)[2][2][4][2], const Unit& u, int wr, int wc, int fr, int fq) const {
        const int row0 = u.pm * BM + wr * 64 + fr, col0 = u.pn * BM + wc * 32 + 4 * fq;
#pragma unroll
        for (int ai = 0; ai < 2; ++ai)
#pragma unroll
            for (int m = 0; m < 4; ++m) { const int r = row0 + ai * HALF + m * 16; float s = 0.f;
#pragma unroll
                for (int bj = 0; bj < 2; ++bj)
#pragma unroll
                    for (int n = 0; n < 2; ++n) { const f32x4 x = acc[ai][bj][m][n]; s += (x[0] * x[0] + x[1] * x[1]) + (x[2] * x[2] + x[3] * x[3]); *(f32x4*)(out + (size_t)r * ldc + col0 + bj * HALF + n * 16) = x; }
                s += __shfl_xor(s, 16); s += __shfl_xor(s, 32);
                if (fq == 0) ssp[(size_t)r * 16 + u.pn * 4 + wc] = s; }
    }
};

struct EpiBf16Raw {
    static constexpr bool PERM = true, AFTER_DRAIN = false;
    bf16_t* O; int ldc;
    __device__ __forceinline__ void operator()(const f32x4 (&acc)[2][2][4][2], const Unit& u, int wr, int wc, int fr, int fq) const {
        const int row0 = u.pm * BM + wr * 64 + fr, col0 = u.pn * BM + wc * 32 + 8 * fq;
#pragma unroll
        for (int ai = 0; ai < 2; ++ai)
#pragma unroll
            for (int m = 0; m < 4; ++m) { bf16_t* rowp = O + (size_t)(row0 + ai * HALF + m * 16) * ldc + col0;
#pragma unroll
                for (int bj = 0; bj < 2; ++bj) { const f32x4 v0 = acc[ai][bj][m][0], v1 = acc[ai][bj][m][1];
                    u32x4 w; w.x = cvt_pk_bf16(v0[0], v0[1]); w.y = cvt_pk_bf16(v0[2], v0[3]); w.z = cvt_pk_bf16(v1[0], v1[1]); w.w = cvt_pk_bf16(v1[2], v1[3]);
                    *(u32x4*)(rowp + bj * HALF) = w; } }
    }
};

template <class Epi, class Sched, bool ALIGN_EPI = false, bool SP2 = false>
__device__ __forceinline__ void gemm_phase(PG8_LAS unsigned char* lds, const Gemm g, const Sched& S, const Epi& E, const int wave_id) {
    const int wid = wave_id, lane = hw_lane(), tid = wid * 64 + lane, wr = wid >> 2, wc = wid & 3, fr = lane & 15, fq = lane >> 4;
    const int K = g.K, nt = K / BK;
    unsigned voffA[2], voffB[2];
#pragma unroll
    for (int i = 0; i < 2; ++i) { int R, C; stage_rc(tid * 16 + i * 8192, R, C); const int Rb = Epi::PERM ? ((R & ~31) + perm32(R & 31)) : R;
        voffA[i] = (unsigned)(R * K + C) * 2u; voffB[i] = (unsigned)(Rb * K + C) * 2u; }
    const size_t kstep = (size_t)(BK * 2);
    const size_t hstep = (size_t)HALF * K * 2;
    const size_t tstep = 2 * hstep;
    const unsigned ldsw = (unsigned)wid * 1024u;
    const int aoff = lds_byte(wr * 64 + fr, fq * 8), boff = lds_byte(wc * 32 + fr, fq * 8);
#define PG8_SA(b, h) (((b) * 2 + (h)) * HTB)
#define PG8_SB(b, h) ((4 + (b) * 2 + (h)) * HTB)
#define PG8_STAGE(bufoff, gbase, voff) do { _Pragma("unroll") for (int _i = 0; _i < 2; ++_i) \
        __builtin_amdgcn_global_load_lds((const unsigned*)((const char*)(gbase) + (voff)[_i]), (PG8_LAS unsigned*)(lds + (bufoff) + ldsw + _i * 8192), 16, 0, 0); } while (0)
#define PG8_LDA(dst, b, h) do { _Pragma("unroll") for (int m = 0; m < 4; ++m) _Pragma("unroll") for (int k = 0; k < 2; ++k) dst[m][k] = *(const PG8_LAS bf16x8*)(lds + PG8_SA(b, h) + aoff + m * 2048 + k * 1024); } while (0)
#define PG8_LDB(dst, b, h) do { _Pragma("unroll") for (int n = 0; n < 2; ++n) _Pragma("unroll") for (int k = 0; k < 2; ++k) dst[n][k] = *(const PG8_LAS bf16x8*)(lds + PG8_SB(b, h) + boff + n * 2048 + k * 1024); } while (0)
#define PG8_MMA(ai, bj, At, Bt) do { __builtin_amdgcn_s_setprio(1); _Pragma("unroll") for (int m = 0; m < 4; ++m) _Pragma("unroll") for (int n = 0; n < 2; ++n) _Pragma("unroll") for (int k = 0; k < 2; ++k) \
        acc[ai][bj][m][n] = __builtin_amdgcn_mfma_f32_16x16x32_bf16(Bt[n][k], At[m][k], acc[ai][bj][m][n], 0, 0, 0); __builtin_amdgcn_s_setprio(0); } while (0)
#define PG8_WAIT_V(n) asm volatile("s_waitcnt vmcnt(" #n ")" ::: "memory")
#define PG8_WAIT_L(n) asm volatile("s_waitcnt lgkmcnt(" #n ")" ::: "memory")
#define PG8_BAR __builtin_amdgcn_s_barrier()
#define PG8_SCHED __builtin_amdgcn_sched_barrier(0)
    Unit cur, nxt; int ui = 0;
    if (!S.next(0, cur)) return;
    f32x4 acc[2][2][4][2];
#pragma unroll
    for (int a = 0; a < 2; ++a)
#pragma unroll
        for (int b = 0; b < 2; ++b)
#pragma unroll
            for (int m = 0; m < 4; ++m)
#pragma unroll
                for (int n = 0; n < 2; ++n) acc[a][b][m][n] = (f32x4){0.f, 0.f, 0.f, 0.f};
    bf16x8 At[4][2], B0[2][2], B1[2][2];
    const char* cA = S.pa(g, cur); const char* cB = S.pb(g, cur);
    S.a_ready(cur);
    if constexpr (SP2) {
        PG8_STAGE(PG8_SB(0, 0), cB, voffB); PG8_STAGE(PG8_SB(0, 1), cB + hstep, voffB); PG8_STAGE(PG8_SA(0, 0), cA, voffA); PG8_STAGE(PG8_SA(0, 1), cA + hstep, voffA);
        if (wr == 1) PG8_BAR;
        PG8_WAIT_V(2); PG8_BAR;
        PG8_STAGE(PG8_SB(1, 0), cB + kstep, voffB); PG8_STAGE(PG8_SA(1, 0), cA + kstep, voffA); PG8_STAGE(PG8_SB(1, 1), cB + hstep + kstep, voffB);
        PG8_WAIT_V(6); PG8_BAR;
    } else {
        PG8_STAGE(PG8_SB(0, 0), cB, voffB); PG8_STAGE(PG8_SA(0, 0), cA, voffA); PG8_STAGE(PG8_SB(0, 1), cB + hstep, voffB); PG8_STAGE(PG8_SA(0, 1), cA + hstep, voffA);
        if (wr == 1) PG8_BAR;
        PG8_WAIT_V(4); PG8_BAR;
        PG8_STAGE(PG8_SB(1, 0), cB + kstep, voffB); PG8_STAGE(PG8_SA(1, 0), cA + kstep, voffA); PG8_STAGE(PG8_SB(1, 1), cB + hstep + kstep, voffB);
        PG8_WAIT_V(6); PG8_BAR;
    }
    for (;;) {
        const bool has_next = S.next(ui + 1, nxt);
        const char* nA = has_next ? S.pa(g, nxt) : cA; const char* nB = has_next ? S.pb(g, nxt) : cB;
        for (int t = 0; t < nt; t += 2) {
            const bool last = (t == nt - 2);
            const char* a1 = cA + (size_t)(t + 1) * kstep;
            const char* a2 = last ? nA : cA + (size_t)(t + 2) * kstep; const char* b2 = last ? nB : cB + (size_t)(t + 2) * kstep;
            const char* a3 = a2 + kstep; const char* b3 = b2 + kstep;
            if (last && has_next) S.a_ready(nxt);
            if constexpr (SP2) {
            PG8_LDB(B0, 0, 0); PG8_LDB(B1, 0, 1); PG8_SCHED; PG8_LDA(At, 0, 0); PG8_STAGE(PG8_SA(1, 1), a1 + hstep, voffA);
            PG8_WAIT_V(8); PG8_WAIT_L(0); PG8_BAR; PG8_MMA(0, 0, At, B0); PG8_MMA(0, 1, At, B1); PG8_BAR; PG8_SCHED;
            PG8_LDA(At, 0, 1); PG8_STAGE(PG8_SB(0, 0), b2, voffB); PG8_STAGE(PG8_SB(0, 1), b2 + hstep, voffB); PG8_STAGE(PG8_SA(0, 0), a2, voffA);
            PG8_WAIT_V(8); PG8_WAIT_L(0); PG8_BAR; PG8_MMA(1, 0, At, B0); PG8_MMA(1, 1, At, B1); PG8_BAR; PG8_SCHED;
            PG8_LDB(B0, 1, 0); PG8_LDB(B1, 1, 1); PG8_SCHED; PG8_LDA(At, 1, 0); PG8_STAGE(PG8_SA(0, 1), a2 + hstep, voffA);
            PG8_WAIT_V(8); PG8_WAIT_L(0); PG8_BAR; PG8_MMA(0, 0, At, B0); PG8_MMA(0, 1, At, B1); PG8_BAR; PG8_SCHED;
            PG8_LDA(At, 1, 1); PG8_STAGE(PG8_SB(1, 0), b3, voffB); PG8_STAGE(PG8_SB(1, 1), b3 + hstep, voffB); PG8_STAGE(PG8_SA(1, 0), a3, voffA);
            PG8_WAIT_V(8); PG8_WAIT_L(0); PG8_BAR; PG8_MMA(1, 0, At, B0); PG8_MMA(1, 1, At, B1); PG8_BAR; PG8_SCHED;
            } else {
            PG8_LDB(B0, 0, 0); PG8_SCHED; PG8_LDA(At, 0, 0); PG8_STAGE(PG8_SA(1, 1), a1 + hstep, voffA);
            PG8_WAIT_L(8); PG8_BAR; PG8_WAIT_L(0); PG8_MMA(0, 0, At, B0); PG8_BAR; PG8_SCHED;
            PG8_LDB(B1, 0, 1); PG8_STAGE(PG8_SB(0, 0), b2, voffB);
            PG8_BAR; PG8_WAIT_L(0); PG8_MMA(0, 1, At, B1); PG8_BAR;
            PG8_LDA(At, 0, 1); PG8_STAGE(PG8_SA(0, 0), a2, voffA);
            PG8_BAR; PG8_WAIT_L(0); PG8_MMA(1, 0, At, B0); PG8_BAR; PG8_SCHED;
            PG8_STAGE(PG8_SB(0, 1), b2 + hstep, voffB);
            PG8_WAIT_V(6); PG8_BAR; PG8_MMA(1, 1, At, B1); PG8_BAR;
            PG8_LDB(B0, 1, 0); PG8_SCHED; PG8_LDA(At, 1, 0); PG8_STAGE(PG8_SA(0, 1), a2 + hstep, voffA);
            PG8_WAIT_L(8); PG8_BAR; PG8_WAIT_L(0); PG8_MMA(0, 0, At, B0); PG8_BAR; PG8_SCHED;
            PG8_LDB(B1, 1, 1); PG8_STAGE(PG8_SB(1, 0), b3, voffB);
            PG8_BAR; PG8_WAIT_L(0); PG8_MMA(0, 1, At, B1); PG8_BAR;
            PG8_LDA(At, 1, 1); PG8_STAGE(PG8_SA(1, 0), a3, voffA);
            PG8_BAR; PG8_WAIT_L(0); PG8_MMA(1, 0, At, B0); PG8_BAR; PG8_SCHED;
            PG8_STAGE(PG8_SB(1, 1), b3 + hstep, voffB);
            PG8_WAIT_V(6); PG8_BAR; PG8_MMA(1, 1, At, B1); PG8_BAR;
            }
        }
        if constexpr (ALIGN_EPI) { if (wr == 0) PG8_BAR; }
        if constexpr (!Epi::AFTER_DRAIN) { E(acc, cur, wr, wc, fr, fq); S.done(cur); }
        if (!has_next) break;
#pragma unroll
        for (int a = 0; a < 2; ++a)
#pragma unroll
            for (int b = 0; b < 2; ++b)
#pragma unroll
                for (int m = 0; m < 4; ++m)
#pragma unroll
                    for (int n = 0; n < 2; ++n) acc[a][b][m][n] = (f32x4){0.f, 0.f, 0.f, 0.f};
        cur = nxt; cA = nA; cB = nB; ++ui;
        if constexpr (ALIGN_EPI) { if (wr == 1) PG8_BAR; }
    }
    PG8_WAIT_V(0);
    if constexpr (!ALIGN_EPI) { if (wr == 0) PG8_BAR; }
    PG8_BAR;
    if constexpr (Epi::AFTER_DRAIN) { E.fused(acc, cur, wr, wc, fr, fq, lds, wid, lane); S.done(cur); }
#undef PG8_SA
#undef PG8_SB
#undef PG8_STAGE
#undef PG8_LDA
#undef PG8_LDB
#undef PG8_MMA
#undef PG8_WAIT_V
#undef PG8_WAIT_L
#undef PG8_BAR
#undef PG8_SCHED
}
}

constexpr int NWAVES = 8;
#ifndef MK_ONE_LAUNCH
#define MK_ONE_LAUNCH 1
#endif
constexpr int N_PHASES = 13;

constexpr int BATCH = 8, SEQ = 2048, D = 1024, M = BATCH * SEQ;
constexpr int IN_COLS = 9472, N1 = 7424;
constexpr int DFF = 2816, NUP = 2 * DFF;
constexpr int MH = M / 2;
constexpr float EPS = 1e-6f, GN_EPS = 64e-5f;

constexpr size_t MiB = 1u << 20;
constexpr size_t WS_CTL = 0;
constexpr size_t WS_W1 = 1 * MiB, WS_W3 = 16 * MiB, WS_WOUT = 24 * MiB, WS_WUP = 26 * MiB, WS_WDN = 37 * MiB, WS_LORA = 43 * MiB;
constexpr size_t WS_Q = 44 * MiB, WS_KF = 76 * MiB, WS_HG = 108 * MiB, WS_R = 140 * MiB, WS_K = 172 * MiB, WS_LZ = 204 * MiB, WS_VI = 212 * MiB;
constexpr size_t WS_SS1 = 244 * MiB, WS_SS3 = 252 * MiB;
constexpr size_t WS_LA = 245 * MiB;
constexpr size_t WS_SCR = 76 * MiB;
constexpr size_t WS_MRG = WS_Q;
constexpr size_t WS_MIX = 76 * MiB;
constexpr size_t WS_HB = WS_Q;
constexpr size_t WS_HU = 76 * MiB;
constexpr size_t WS_ACT = 164 * MiB;
constexpr size_t WS_END = 256 * MiB;
constexpr size_t OUT_XN = 0, OUT_V = 32 * MiB;

constexpr int LDS_BYTES = 147456;

#define GAS __attribute__((address_space(1)))
#define LAS __attribute__((address_space(3)))
typedef unsigned short bf16;
typedef unsigned v4u __attribute__((ext_vector_type(4)));
typedef unsigned v2u __attribute__((ext_vector_type(2)));
typedef float f32x4 __attribute__((ext_vector_type(4)));
typedef float f32x2 __attribute__((ext_vector_type(2)));
typedef short bf16x8 __attribute__((ext_vector_type(8)));
#define LDS_WAIT() asm volatile("s_waitcnt lgkmcnt(0)" ::: "memory")
#define VM_WAIT() asm volatile("s_waitcnt vmcnt(0)" ::: "memory")
__device__ __forceinline__ unsigned f2bf(float f) { return (unsigned)__builtin_bit_cast(unsigned short, (__bf16)f); }
__device__ __forceinline__ unsigned pk2(float lo, float hi) { return pg8::cvt_pk_bf16(lo, hi); }
__device__ __forceinline__ float bf_lo(unsigned u) { return __builtin_bit_cast(float, u << 16); }
__device__ __forceinline__ float bf_hi(unsigned u) { return __builtin_bit_cast(float, u & 0xffff0000u); }
__device__ __forceinline__ float bf1(unsigned short u) { return __builtin_bit_cast(float, (unsigned)u << 16); }
__device__ __forceinline__ float h1(unsigned short u) { return (float)__builtin_bit_cast(_Float16, u); }
__device__ __forceinline__ float fsig(float x) { return __builtin_amdgcn_rcpf(1.0f + __expf(-x)); }
__device__ __forceinline__ float wave_sum(float v) {
#pragma unroll
    for (int o = 1; o < 64; o <<= 1) v += __shfl_xor(v, o);
    return v;
}
template <int CTRL> __device__ __forceinline__ float dpp_f(float x) { return __builtin_bit_cast(float, __builtin_amdgcn_mov_dpp(__builtin_bit_cast(int, x), CTRL, 0xf, 0xf, false)); }
__device__ __forceinline__ float red16(float x) {
    x += dpp_f<0x128>(x); x += dpp_f<0x124>(x); x += dpp_f<0x122>(x); x += dpp_f<0x121>(x); return x;
}

#define XB_TMO      128
#define XB_XCNT(j)  (256  + 64 * (j))
#define XB_XSUB(j)  (1280 + 64 * (j))
#define XB_XGEN(j)  (2304 + 64 * (j))
#define XB_TOP      3328
#define XB_TOPGEN   3392
#define XCD_BAR_WORDS 3456
#define XB_SPIN_CAP (1u << 18)

__device__ __forceinline__ unsigned xb_ld(unsigned* p)              { return __hip_atomic_load(p, __ATOMIC_RELAXED, __HIP_MEMORY_SCOPE_AGENT); }
__device__ __forceinline__ unsigned xb_add(unsigned* p, unsigned v) { return __hip_atomic_fetch_add(p, v, __ATOMIC_RELAXED, __HIP_MEMORY_SCOPE_AGENT); }
__device__ __forceinline__ unsigned xb_xcc_id() { return (unsigned)__builtin_amdgcn_s_getreg((3 << 11) | 20) & 0xFu; }
#define XB_SPIN(cond, bar) do { unsigned _sp = 0; while (cond) { __builtin_amdgcn_s_sleep(1); \
    if ((++_sp & 255u) == 0u) { if (xb_ld(&(bar)[XB_TMO])) break; if (_sp > XB_SPIN_CAP) { atomicAdd(&(bar)[XB_TMO], 1u); break; } } } } while (0)

struct XcdBarrier {
    unsigned* bar; unsigned x, w;
    volatile LAS unsigned* st;
};

__device__ __forceinline__ XcdBarrier xcd_barrier_post(unsigned* bar, volatile LAS unsigned* st) {
    XcdBarrier b; b.bar = bar; b.x = xb_xcc_id(); b.st = st; b.w = 0u;
    if (__builtin_amdgcn_readfirstlane(threadIdx.x) == 0 && hw_lane() == 0) (void)xb_add(&bar[XB_XCNT(b.x)], 1u);
    return b;
}
__device__ __forceinline__ void xcd_barrier_complete(unsigned* bar, unsigned x, unsigned& nloc, unsigned& nx) {
    const unsigned G = gridDim.x * gridDim.y * gridDim.z;
    unsigned sum, cnt, mine, sp = 0u;
    for (;;) {
        sum = 0u; cnt = 0u; mine = 0u;
#pragma unroll
        for (unsigned j = 0; j < 16; ++j) { const unsigned c = xb_ld(&bar[XB_XCNT(j)]); sum += c; cnt += (c > 0u) ? 1u : 0u; mine = (j == x) ? c : mine; }
        if (sum == G) break;
        __builtin_amdgcn_s_sleep(1);
        if ((++sp & 255u) == 0u) { if (xb_ld(&bar[XB_TMO])) break; if (sp > XB_SPIN_CAP) { atomicAdd(&bar[XB_TMO], 1u); break; } }
    }
    nloc = mine > 0u ? mine : 1u; nx = cnt > 0u ? cnt : 1u;
}

__device__ __forceinline__ void xcd_barrier(const XcdBarrier& b) {
    asm volatile("s_waitcnt vmcnt(0)" ::: "memory");
    __syncthreads();
    if (b.w == 0u && hw_lane() == 0) {
        unsigned* bar = b.bar;
        __builtin_amdgcn_s_waitcnt(0);
        unsigned nloc = b.st[0], nx = b.st[1];
        if (nloc == 0u) { xcd_barrier_complete(bar, b.x, nloc, nx); b.st[0] = nloc; b.st[1] = nx; }
        const unsigned old = xb_add(&bar[XB_XSUB(b.x)], 1u);
        const unsigned gen = old / nloc;
        if (old + 1u == (gen + 1u) * nloc) {
            __builtin_amdgcn_fence(__ATOMIC_RELEASE, "agent");
            asm volatile("s_waitcnt vmcnt(0)" ::: "memory");
            const unsigned og = xb_add(&bar[XB_TOP], 1u);
            const unsigned tg = og / nx;
            if (og + 1u == (tg + 1u) * nx) xb_add(&bar[XB_TOPGEN], 1u);
            else XB_SPIN(xb_ld(&bar[XB_TOPGEN]) == tg, bar);
            __builtin_amdgcn_fence(__ATOMIC_ACQUIRE, "agent");
            xb_add(&bar[XB_XGEN(b.x)], 1u);
            asm volatile("s_waitcnt vmcnt(0)" ::: "memory");
        } else {
            XB_SPIN(xb_ld(&bar[XB_XGEN(b.x)]) == gen, bar);
            __builtin_amdgcn_fence(__ATOMIC_ACQUIRE, "agent");
            asm volatile("s_waitcnt vmcnt(0)" ::: "memory");
        }
    }
    __syncthreads();
}


constexpr int CW_BAR = 4096;
constexpr int MISC_OFF = LDS_BYTES - 64;

struct Frame {
    LAS unsigned char* lds;
    int tid, lane, wave, G, bid;
    float* out; unsigned char* ws;
};
__device__ __forceinline__ const float* inp(int i) { const float* const* ka = (const float* const*)__builtin_amdgcn_kernarg_segment_ptr(); return ka[i]; }

__device__ __forceinline__ void p0_tr_item(const float* W, int ldw, int n0, int K, bf16* WT, int r0, int nblk, LAS float* scr, int item, int lane) {
    const int kb = item / nblk, nb = item % nblk, k0 = 64 * kb, nn = 32 * nb;
#pragma unroll 8
    for (int i = 0; i < 32; ++i) { const int kk = 2 * i + (lane >> 5); scr[kk * 33 + (lane & 31)] = W[(size_t)(k0 + kk) * ldw + n0 + nn + (lane & 31)]; }
    LDS_WAIT(); asm volatile("" ::: "memory");
    const int c = lane & 7;
#pragma unroll
    for (int j = 0; j < 4; ++j) { const int n = (lane >> 3) + 8 * j; const LAS float* s = scr + (8 * c) * 33 + n;
        v4u o; o.x = pk2(s[0 * 33], s[1 * 33]); o.y = pk2(s[2 * 33], s[3 * 33]); o.z = pk2(s[4 * 33], s[5 * 33]); o.w = pk2(s[6 * 33], s[7 * 33]);
        *(GAS v4u*)(WT + (size_t)(r0 + nn + n) * K + k0 + 8 * c) = o; }
    LDS_WAIT(); asm volatile("" ::: "memory");
}
__device__ __forceinline__ void rms_row_to_bf16(int lane, const float* xrow, const float* g, bf16* orow) {
    const GAS f32x4* xr = (const GAS f32x4*)xrow + lane; const GAS f32x4* gr = (const GAS f32x4*)g + lane;
    f32x4 v[4]; float s = 0.f;
#pragma unroll
    for (int j = 0; j < 4; ++j) { v[j] = xr[64 * j]; s += (v[j].x * v[j].x + v[j].y * v[j].y) + (v[j].z * v[j].z + v[j].w * v[j].w); }
    const float rstd = __builtin_amdgcn_rsqf(wave_sum(s) * (1.f / D) + EPS);
    GAS unsigned long long* o8 = (GAS unsigned long long*)orow + lane;
#pragma unroll
    for (int j = 0; j < 4; ++j) { const f32x4 gg = gr[64 * j]; o8[64 * j] = (unsigned long long)pk2(v[j].x * rstd * gg.x, v[j].y * rstd * gg.y) | ((unsigned long long)pk2(v[j].z * rstd * gg.z, v[j].w * rstd * gg.w) << 32); }
}
__device__ __forceinline__ void p0_prologue(Frame& F) {
    LAS float* scr = (LAS float*)(F.lds + F.wave * 16384);
    const int gw = F.bid * NWAVES + F.wave, NGW = F.G * NWAVES;
    const float* w_in = inp(2);
    bf16* W1 = (bf16*)(F.ws + WS_W1); bf16* W3 = (bf16*)(F.ws + WS_W3); bf16* WO = (bf16*)(F.ws + WS_WOUT); bf16* WU = (bf16*)(F.ws + WS_WUP); bf16* WD = (bf16*)(F.ws + WS_WDN);
    bf16* L2 = (bf16*)(F.ws + WS_LORA);
    constexpr int I_A = 16 * (N1 / 32), I_G = 16 * 32, I_UP = 16 * (NUP / 32), I_DN = (DFF / 64) * 32, I_L64 = 32, I_L128 = 64;
    constexpr int NITEMS = I_A + 5 * I_G + I_UP + I_DN + 2 * I_L64 + I_L128;
    for (int it = gw; it < NITEMS; it += NGW) {
        int r = it;
        if (r < I_A) { p0_tr_item(w_in, IN_COLS, 0, D, W1, 0, N1 / 32, scr, r, F.lane); continue; } r -= I_A;
        if (r < I_G) { p0_tr_item(w_in, IN_COLS, N1, D, W3, 0, 32, scr, r, F.lane); continue; } r -= I_G;
        if (r < I_G) { p0_tr_item(inp(5), D, 0, D, W3, 1024, 32, scr, r, F.lane); continue; } r -= I_G;
        if (r < I_G) { p0_tr_item(w_in, IN_COLS, N1 + 1024, D, W3, 2048, 32, scr, r, F.lane); continue; } r -= I_G;
        if (r < I_G) { p0_tr_item(inp(17), D, 0, D, W3, 3072, 32, scr, r, F.lane); continue; } r -= I_G;
        if (r < I_G) { p0_tr_item(inp(18), D, 0, D, WO, 0, 32, scr, r, F.lane); continue; } r -= I_G;
        if (r < I_UP) { p0_tr_item(inp(21), NUP, 0, D, WU, 0, NUP / 32, scr, r, F.lane); continue; } r -= I_UP;
        if (r < I_DN) { p0_tr_item(inp(24), D, 0, DFF, WD, 0, 32, scr, r, F.lane); continue; } r -= I_DN;
        if (r < I_L64) { p0_tr_item(inp(8), D, 0, 64, L2, 0, 32, scr, r, F.lane); continue; } r -= I_L64;
        if (r < I_L64) { p0_tr_item(inp(10), D, 0, 64, L2 + 65536, 0, 32, scr, r, F.lane); continue; } r -= I_L64;
        p0_tr_item(inp(11), D, 0, 128, L2 + 131072, 0, 32, scr, r, F.lane);
    }
    bf16* XN = (bf16*)((unsigned char*)F.out + OUT_XN);
    for (int m = gw; m < M; m += NGW) rms_row_to_bf16(F.lane, inp(0) + (size_t)m * D, inp(1), XN + (size_t)m * D);
}

__device__ __forceinline__ void la_phase(Frame& F) {
    const bf16* LZg = (const bf16*)(F.ws + WS_LZ); bf16* LAg = (bf16*)(F.ws + WS_LA); const float* mu = inp(6) + 3072;
    for (int task = F.bid * 512 + F.tid; task < M * 32; task += F.G * 512) { const int t = task >> 5, c = (task & 31) * 8;
        const v4u cur = *(const GAS v4u*)(LZg + (size_t)t * 256 + c); v4u prv = (v4u){0u, 0u, 0u, 0u}; if (t % SEQ) prv = *(const GAS v4u*)(LZg + (size_t)(t - 1) * 256 + c);
        const unsigned cu[4] = {cur.x, cur.y, cur.z, cur.w}, pu[4] = {prv.x, prv.y, prv.z, prv.w}; float x[8];
#pragma unroll
        for (int e = 0; e < 4; ++e) { const float z0 = bf_lo(cu[e]), z1 = bf_hi(cu[e]), p0 = bf_lo(pu[e]), p1 = bf_hi(pu[e]); x[2 * e] = z0 + mu[c + 2 * e] * (p0 - z0); x[2 * e + 1] = z1 + mu[c + 2 * e + 1] * (p1 - z1); }
        if (c < 64) {
#pragma unroll
            for (int e = 0; e < 8; ++e) x[e] = 1.f - 2.f * __builtin_amdgcn_rcpf(__expf(2.f * x[e]) + 1.f);
        } else if (c >= 128) {
#pragma unroll
            for (int e = 0; e < 8; ++e) x[e] = fsig(x[e]);
        }
        *(GAS v4u*)(LAg + (size_t)t * 256 + c) = (v4u){pk2(x[0], x[1]), pk2(x[2], x[3]), pk2(x[4], x[5]), pk2(x[6], x[7])}; }
}

__device__ __forceinline__ unsigned pk2r(float lo, float hi) { return pg8::cvt_pk_bf16(lo, hi); }
__device__ __forceinline__ bf16x8 mk8(unsigned a, unsigned b, unsigned c, unsigned d) { v4u u = {a, b, c, d}; return __builtin_bit_cast(bf16x8, u); }
__device__ __forceinline__ bf16x8 op4(const pg8::f32x4 x) { return mk8(pk2r(x[0], x[1]), pk2r(x[2], x[3]), 0u, 0u); }
__device__ __forceinline__ bf16x8 op44(const pg8::f32x4 x, const pg8::f32x4 y) { return mk8(pk2r(x[0], x[1]), pk2r(x[2], x[3]), pk2r(y[0], y[1]), pk2r(y[2], y[3])); }
#define MFMA16(a, b, c) __builtin_amdgcn_mfma_f32_16x16x32_bf16((a), (b), (c), 0, 0, 0)
__device__ __forceinline__ void rwkv_phase(Frame& F, int bh, bool dry) {
    typedef pg8::f32x4 f4;
    const int b = bh >> 4, h = bh & 15, tid = F.tid, lane = F.lane, wv = F.wave, fr = lane & 15, fq = lane >> 4;
    LAS unsigned char* L = F.lds;
    constexpr int SLOT = 17664, O_AR = 0, O_BKY = 4608, O_BTK = 9216, O_VF = 13312, O_A2 = 15360, O_M2 = 16384, O_WC = 17408, O_MU = 8 * SLOT, O_CST = O_MU + 1024, O_CARRY = O_CST + 2560;
    const bf16* L2 = (const bf16*)(F.ws + WS_LORA);
    const size_t rowbase = (size_t)b * SEQ;
    const GAS char* bR = (const GAS char*)(F.ws + WS_R) + (rowbase * D + h * 64) * 2; const GAS char* bK = (const GAS char*)(F.ws + WS_K) + (rowbase * D + h * 64) * 2;
    const GAS char* bV = (const GAS char*)((unsigned char*)F.out + OUT_V) + (rowbase * D + h * 64) * 2; GAS char* bO = (GAS char*)((unsigned char*)F.out + OUT_V) + (rowbase * D + h * 64) * 2;
    const GAS char* bLZ = (const GAS char*)(F.ws + WS_LA) + rowbase * 512;
    const GAS char* bW2 = (const GAS char*)L2 + (size_t)h * 64 * 128, *bA2 = (const GAS char*)L2 + 131072 + (size_t)h * 64 * 128, *bG2 = (const GAS char*)L2 + 262144 + (size_t)h * 64 * 256;
    const float* mu = inp(6);
    for (int u = tid; u < 640; u += 512) { const int c = u >> 6, col = h * 64 + (u & 63);
        const float val = c == 0 ? inp(7)[col] : c == 1 ? inp(9)[col] : c == 2 ? inp(12)[col] : c == 3 ? inp(13)[col] : c == 4 ? inp(14)[col] : c == 5 ? inp(15)[col] : c == 6 ? inp(16)[col] : c == 7 ? mu[col] : c == 8 ? mu[1024 + col] : mu[2048 + col];
        ((LAS float*)(L + O_CST))[u] = val; }
#define CST(c, nt) (((const LAS float*)(L + O_CST))[(c) * 64 + 16 * (nt) + fr])
    LAS unsigned char* myslot = L + wv * SLOT;
    f4 St[4];
#pragma unroll
    for (int t = 0; t < 4; ++t) St[t] = (f4){0.f, 0.f, 0.f, 0.f};
    v4u lzc[8], rkv[7];
#define RW_LOAD_LZ(T0) do { const unsigned oc = (unsigned)((T0) + fr) * 512u + fq * 16u; \
        _Pragma("unroll") for (int s = 0; s < 8; ++s) lzc[s] = *(const GAS v4u*)(bLZ + (oc + s * 64u)); } while (0)
#define RW_LOAD_RKV(T0) do { const int tt0 = (T0); const unsigned tpv = (unsigned)(tt0 > 0 ? tt0 - 1 : 0); \
        _Pragma("unroll") for (int jj = 0; jj < 2; ++jj) { const int q = lane + 64 * jj; const unsigned o = (unsigned)(tt0 + (q >> 3)) * 2048u + (q & 7) * 16u; \
            rkv[jj] = *(const GAS v4u*)(bR + o); rkv[2 + jj] = *(const GAS v4u*)(bK + o); rkv[4 + jj] = *(const GAS v4u*)(bV + o); } \
        { const GAS char* pb_ = lane < 8 ? bR : lane < 16 ? bK : bV; rkv[6] = *(const GAS v4u*)(pb_ + (tpv * 2048u + (lane & 7) * 16u)); } } while (0)
    RW_LOAD_LZ(16 * wv); RW_LOAD_RKV(16 * wv);
    unsigned ggp[4][2]; float bonus[4];
    __syncthreads();
    const int lane_o = lane;
    for (int rnd = 0; rnd < SEQ / 128; ++rnd) {
        const int t0 = rnd * 128 + 16 * wv;
        int oz_; asm volatile("v_mov_b32 %0, 0" : "=v"(oz_));
        const int lane = lane_o + oz_, fr = lane & 15, fq = lane >> 4;
        {
            bf16x8 afr[8];
#pragma unroll
            for (int s = 0; s < 8; ++s) afr[s] = __builtin_bit_cast(bf16x8, lzc[s]);
            __builtin_amdgcn_sched_barrier(0);
#pragma unroll
            for (int jj = 0; jj < 2; ++jj) { const int q = lane + 64 * jj;
#pragma unroll
                for (int x3 = 0; x3 < 3; ++x3) *(LAS v4u*)(myslot + (1 + (q >> 3)) * 400 + x3 * 128 + (q & 7) * 16) = rkv[2 * x3 + jj]; }
            { v4u pr = rkv[6];
              if (wv == 0 && rnd > 0 && lane >= 16 && lane < 24) pr = *(const LAS v4u*)(L + O_CARRY + ((rnd - 1) & 1) * 128 + (lane & 7) * 16);
              if (wv == 7 && lane >= 56) *(LAS v4u*)(L + O_CARRY + (rnd & 1) * 128 + (lane - 56) * 16) = rkv[5];
              if (lane < 24) *(LAS v4u*)(myslot + (lane >> 3) * 128 + (lane & 7) * 16) = (t0 == 0) ? (v4u){0u, 0u, 0u, 0u} : pr; }
            LDS_WAIT(); asm volatile("" ::: "memory");
            __builtin_amdgcn_sched_barrier(0);
            float wd[4][4], asg[4][4];
            bf16x8 bq[2][8];
#define RW_LDB(dst, NT) do { const unsigned o64 = (unsigned)(16 * (NT) + fr) * 128u + fq * 16u, o128 = (unsigned)(16 * (NT) + fr) * 256u + fq * 16u; \
                _Pragma("unroll") for (int s = 0; s < 2; ++s) { dst[s] = *(const GAS bf16x8*)(bW2 + (o64 + s * 64u)); dst[2 + s] = *(const GAS bf16x8*)(bA2 + (o64 + s * 64u)); } \
                _Pragma("unroll") for (int s = 0; s < 4; ++s) dst[4 + s] = *(const GAS bf16x8*)(bG2 + (o128 + s * 64u)); } while (0)
            RW_LDB(bq[0], 0);
#pragma unroll
            for (int nt = 0; nt < 4; ++nt) {
                if (nt < 3) RW_LDB(bq[(nt + 1) & 1], nt + 1);
                asm volatile("" ::: "memory");
                f4 cw = {0.f, 0.f, 0.f, 0.f}, ca = cw, cgt = cw;
#pragma unroll
                for (int s = 0; s < 2; ++s) { cw = MFMA16(afr[s], bq[nt & 1][s], cw); ca = MFMA16(afr[2 + s], bq[nt & 1][2 + s], ca); }
#pragma unroll
                for (int s = 0; s < 4; ++s) cgt = MFMA16(afr[4 + s], bq[nt & 1][4 + s], cgt);
#pragma unroll
                for (int j = 0; j < 4; ++j) { const float wp = CST(0, nt) + cw[j]; const float wl = fminf(wp, 0.f) - __logf(1.f + __expf(-fabsf(wp))) - 0.5f;
                    wd[nt][j] = __expf(-__expf(wl)); asg[nt][j] = fsig(CST(1, nt) + ca[j]); }
                ggp[nt][0] = pk2r(cgt[0], cgt[1]); ggp[nt][1] = pk2r(cgt[2], cgt[3]);
                __builtin_amdgcn_sched_barrier(0); }
#undef RW_LDB
            __builtin_amdgcn_sched_barrier(0);
            float rl[4][4], kx[4][4], vv[4][4];
            float n2[4] = {0.f, 0.f, 0.f, 0.f}, bo[4] = {0.f, 0.f, 0.f, 0.f};
#pragma unroll
            for (int nt = 0; nt < 4; ++nt)
#pragma unroll
                for (int j = 0; j < 4; ++j) { const LAS unsigned short* sg = (const LAS unsigned short*)myslot + (4 * fq + j) * 200 + 16 * nt + fr;
                    const float r1 = bf1(sg[200]), r0 = bf1(sg[0]), k1 = bf1(sg[200 + 64]), k0 = bf1(sg[64]), v1 = bf1(sg[200 + 128]), v0 = bf1(sg[128]);
                    const float r_ = r1 + CST(7, nt) * (r0 - r1), kx_ = k1 + CST(8, nt) * (k0 - k1), v_ = v1 + CST(9, nt) * (v0 - v1);
                    rl[nt][j] = r_; vv[nt][j] = v_; kx[nt][j] = kx_; const float kkv = kx_ * CST(2, nt); n2[j] += kkv * kkv;
                    bo[j] += r_ * kx_ * (1.f + (asg[nt][j] - 1.f) * CST(3, nt)) * CST(4, nt); if (j == 3) __builtin_amdgcn_sched_barrier(0); }
#pragma unroll
            for (int nt = 0; nt < 4; ++nt) *(LAS v2u*)(myslot + O_VF + (nt * 64 + lane) * 8) = (v2u){pk2r(vv[nt][0], vv[nt][1]), pk2r(vv[nt][2], vv[nt][3])};
            float inv[4];
#pragma unroll
            for (int j = 0; j < 4; ++j) { inv[j] = 1.f / fmaxf(__builtin_sqrtf(red16(n2[j])), 1e-12f); bonus[j] = red16(bo[j]); }
            LDS_WAIT(); asm volatile("" ::: "memory");
            __builtin_amdgcn_sched_barrier(0);
            LAS unsigned short* AR = (LAS unsigned short*)(myslot + O_AR); LAS unsigned short* BK = (LAS unsigned short*)(myslot + O_BKY);
#pragma unroll
            for (int nt = 0; nt < 4; ++nt) { float pf[4]; pf[0] = wd[nt][0]; pf[1] = pf[0] * wd[nt][1]; pf[2] = pf[1] * wd[nt][2]; pf[3] = pf[2] * wd[nt][3];
                const float s0 = __shfl(pf[3], fr), s1 = __shfl(pf[3], fr + 16), s2 = __shfl(pf[3], fr + 32), s3 = __shfl(pf[3], fr + 48);
                const float offs = fq == 0 ? 1.f : fq == 1 ? s0 : fq == 2 ? s0 * s1 : s0 * s1 * s2, WC = (s0 * s1) * (s2 * s3);
                const float ckk = CST(2, nt), cka = CST(3, nt);
                float btv[4], ktv[4];
#pragma unroll
                for (int j = 0; j < 4; ++j) { const float W = offs * pf[j], Wm1 = j == 0 ? offs : offs * pf[j - 1], iW = __builtin_amdgcn_rcpf(W);
                    const float kkn = kx[nt][j] * ckk * inv[j], a_ = asg[nt][j], k2v = kx[nt][j] * (1.f + (a_ - 1.f) * cka);
                    const float ah = -kkn * Wm1, rh = rl[nt][j] * W, bhv = kkn * a_ * iW, khv = k2v * iW; btv[j] = bhv * WC; ktv[j] = khv * WC;
                    const int ix = (4 * fq + j) * 72 + 16 * nt + fr;
                    AR[ix] = (unsigned short)f2bf(ah); AR[16 * 72 + ix] = (unsigned short)f2bf(rh); BK[ix] = (unsigned short)f2bf(bhv); BK[16 * 72 + ix] = (unsigned short)f2bf(khv); }
                *(LAS v4u*)(myslot + O_BTK + (nt * 64 + lane) * 16) = (v4u){pk2r(btv[0], btv[1]), pk2r(btv[2], btv[3]), pk2r(ktv[0], ktv[1]), pk2r(ktv[2], ktv[3])};
                if (fq == 0) ((LAS float*)(myslot + O_WC))[16 * nt + fr] = WC;
                __builtin_amdgcn_sched_barrier(0); }
            LDS_WAIT(); asm volatile("" ::: "memory");
            bf16x8 fa0[2], fa1[2], fb0[2], fb1[2];
#pragma unroll
            for (int s = 0; s < 2; ++s) { fa0[s] = *(const LAS bf16x8*)(myslot + O_AR + (fr * 72 + 32 * s + 8 * fq) * 2); fa1[s] = *(const LAS bf16x8*)(myslot + O_AR + ((16 + fr) * 72 + 32 * s + 8 * fq) * 2);
                fb0[s] = *(const LAS bf16x8*)(myslot + O_BKY + (fr * 72 + 32 * s + 8 * fq) * 2); fb1[s] = *(const LAS bf16x8*)(myslot + O_BKY + ((16 + fr) * 72 + 32 * s + 8 * fq) * 2); }
            const f4 z4 = {0.f, 0.f, 0.f, 0.f};
            f4 Lab = MFMA16(fa0[1], fb0[1], MFMA16(fa0[0], fb0[0], z4)), Lak = MFMA16(fa0[1], fb1[1], MFMA16(fa0[0], fb1[0], z4));
            f4 Lt = MFMA16(fb0[1], fa0[1], MFMA16(fb0[0], fa0[0], z4)), MrbT = MFMA16(fb0[1], fa1[1], MFMA16(fb0[0], fa1[0], z4)), MrkT = MFMA16(fb1[1], fa1[1], MFMA16(fb1[0], fa1[0], z4));
#pragma unroll
            for (int j = 0; j < 4; ++j) { const int ri = 4 * fq + j; Lab[j] = ri > fr ? Lab[j] : 0.f; Lak[j] = ri > fr ? Lak[j] : 0.f; Lt[j] = fr > ri ? Lt[j] : 0.f; MrbT[j] = fr >= ri ? MrbT[j] : 0.f; MrkT[j] = fr >= ri ? MrkT[j] : 0.f; }
            __builtin_amdgcn_sched_barrier(0);
            const bf16x8 oL = op4(Lab), oLt = op4(Lt);
            const f4 L2t = MFMA16(oLt, oL, z4), Lt2 = MFMA16(oL, oLt, z4);
            const bf16x8 oL2 = op4(L2t), oLt2 = op4(Lt2);
            const f4 L4t = MFMA16(oLt2, oL2, z4), Lt4 = MFMA16(oL2, oLt2, z4);
            const bf16x8 oL4 = op4(L4t);
            const f4 L8t = MFMA16(op4(Lt4), oL4, z4);
            f4 X = Lt;
#pragma unroll
            for (int j = 0; j < 4; ++j) X[j] += (4 * fq + j == fr) ? 1.f : 0.f;
            X = MFMA16(oL2, op4(X), X); X = MFMA16(oL4, op4(X), X); X = MFMA16(op4(L8t), op4(X), X);
            const f4 TLt = MFMA16(op4(Lak), op4(X), z4);
            *(LAS bf16x8*)(myslot + O_A2 + lane * 16) = op44(X, TLt);
            *(LAS bf16x8*)(myslot + O_M2 + lane * 16) = op44(MrbT, MrkT);
        }
        LDS_WAIT();
        __syncthreads();
        if (rnd + 1 < SEQ / 128) RW_LOAD_LZ(t0 + 128);
        if (wv < 4) {
#pragma unroll 1
            for (int sl = 0; sl < 8; ++sl) { const LAS unsigned char* sb = L + sl * SLOT;
                const bf16x8 b1a = op44(St[0], St[1]), b1b = op44(St[2], St[3]);
                f4 Pt = {0.f, 0.f, 0.f, 0.f}, Pb = Pt;
#pragma unroll
                for (int s = 0; s < 2; ++s) { const v2u l0 = *(const LAS v2u*)(sb + O_AR + (fr * 72 + 32 * s + 4 * fq) * 2), h0 = *(const LAS v2u*)(sb + O_AR + (fr * 72 + 32 * s + 16 + 4 * fq) * 2);
                    const v2u l1 = *(const LAS v2u*)(sb + O_AR + ((16 + fr) * 72 + 32 * s + 4 * fq) * 2), h1 = *(const LAS v2u*)(sb + O_AR + ((16 + fr) * 72 + 32 * s + 16 + 4 * fq) * 2);
                    Pt = MFMA16(mk8(l0.x, l0.y, h0.x, h0.y), s ? b1b : b1a, Pt); Pb = MFMA16(mk8(l1.x, l1.y, h1.x, h1.y), s ? b1b : b1a, Pb); }
                const v2u vf = *(const LAS v2u*)(sb + O_VF + (wv * 64 + lane) * 8);
                const f4 U = MFMA16(*(const LAS bf16x8*)(sb + O_A2 + lane * 16), mk8(pk2r(Pt[0], Pt[1]), pk2r(Pt[2], Pt[3]), vf.x, vf.y), ((f4){0.f, 0.f, 0.f, 0.f}));
                const bf16x8 b3 = mk8(pk2r(U[0], U[1]), pk2r(U[2], U[3]), vf.x, vf.y);
                const f4 Yt = MFMA16(*(const LAS bf16x8*)(sb + O_M2 + lane * 16), b3, Pb);
#pragma unroll
                for (int t = 0; t < 4; ++t) { const f4 dec = *(const LAS f4*)(sb + O_WC + (16 * t + 4 * fq) * 4); St[t] = MFMA16(*(const LAS bf16x8*)(sb + O_BTK + (t * 64 + lane) * 16), b3, St[t] * dec); }
#pragma unroll
                for (int j = 0; j < 4; ++j) ((LAS float*)(sb + O_BKY))[(4 * fq + j) * 64 + 16 * wv + fr] = Yt[j];
            }
        }
        if (rnd + 1 < SEQ / 128) RW_LOAD_RKV(t0 + 128);
        LDS_WAIT();
        __syncthreads();
        { const LAS float* Yl = (const LAS float*)(myslot + O_BKY) + (4 * fq) * 64 + fr; float mean[4], rs[4];
#pragma unroll
          for (int j = 0; j < 4; ++j) { const float s_ = (Yl[j * 64] + Yl[j * 64 + 16]) + (Yl[j * 64 + 32] + Yl[j * 64 + 48]); mean[j] = red16(s_) * (1.f / 64.f); }
#pragma unroll
          for (int j = 0; j < 4; ++j) { const float d0 = Yl[j * 64] - mean[j], d1 = Yl[j * 64 + 16] - mean[j], d2 = Yl[j * 64 + 32] - mean[j], d3 = Yl[j * 64 + 48] - mean[j];
              rs[j] = __builtin_amdgcn_rsqf(red16((d0 * d0 + d1 * d1) + (d2 * d2 + d3 * d3)) * (1.f / 64.f) + GN_EPS); }
          __builtin_amdgcn_sched_barrier(0);
#pragma unroll
          for (int nt = 0; nt < 4; ++nt) { const v2u vf = *(const LAS v2u*)(myslot + O_VF + (nt * 64 + lane) * 8); const float lw = CST(5, nt), lb = CST(6, nt);
              const float v4_[4] = {bf_lo(vf.x), bf_hi(vf.x), bf_lo(vf.y), bf_hi(vf.y)}, g4_[4] = {bf_lo(ggp[nt][0]), bf_hi(ggp[nt][0]), bf_lo(ggp[nt][1]), bf_hi(ggp[nt][1])};
#pragma unroll
              for (int j = 0; j < 4; ++j) { const float o = ((Yl[j * 64 + 16 * nt] - mean[j]) * rs[j] * lw + lb + bonus[j] * v4_[j]) * g4_[j];
                  if (!dry) *(GAS unsigned short*)(bO + ((unsigned)(t0 + 4 * fq + j) * 2048u + (16 * nt + fr) * 2u)) = (unsigned short)f2bf(o); }
              __builtin_amdgcn_sched_barrier(0); } }
    }
#undef RW_LOAD_LZ
#undef RW_LOAD_RKV
#undef CST
}

__device__ __forceinline__ void hgrn_phase(Frame& F, int bh, bool dry) {
    typedef pg8::f32x4 f4;
    const int b = bh >> 3, h = bh & 7, wv = F.wave, lane_o = F.lane;
    LAS unsigned char* L = F.lds;
    constexpr int SLOT = 33280, O_QD = 0, O_KX = 8704  , O_KT = 18944, O_SC = 29184, O_DEC = 31744, O_SSQ = 32256;
    constexpr int ST_Q = 0, ST_K = 8192, ST_V = 16384;
    const size_t rowbase = (size_t)b * SEQ; const int colb = h * 128;
    const GAS char* bQ = (const GAS char*)(F.ws + WS_Q) + (rowbase * D + colb) * 2; const GAS char* bKF = (const GAS char*)(F.ws + WS_KF) + (rowbase * D + colb) * 2;
    const GAS char* bHG = (const GAS char*)(F.ws + WS_HG) + (rowbase * D + colb) * 2; GAS char* bVI = (GAS char*)(F.ws + WS_VI) + (rowbase * D + colb) * 2;
    const float* gn = inp(4);
    const int cs = wv >> 1, pp = wv & 1;
    LAS unsigned char* ps = L + cs * SLOT;
    f4 St[8];
#pragma unroll
    for (int t = 0; t < 8; ++t) St[t] = (f4){0.f, 0.f, 0.f, 0.f};
    v4u pre[12];
#define HG_LOAD(T0) do { _Pragma("unroll") for (int j = 0; j < 4; ++j) { const int q = lane + 64 * j; const unsigned o = (unsigned)((T0) + (q >> 3)) * 2048u + (unsigned)(64 * pp) * 2u + (q & 7) * 16u; \
        pre[j] = *(const GAS v4u*)(bQ + o); pre[4 + j] = *(const GAS v4u*)(bKF + o); pre[8 + j] = *(const GAS v4u*)(bVI + o); } } while (0)
    { const int lane = lane_o; HG_LOAD(32 * cs); }
    const float g_v = gn[colb + 16 * wv + (lane_o & 15)];
    for (int rnd = 0; rnd < SEQ / 128; ++rnd) {
        int oz_; asm volatile("v_mov_b32 %0, 0" : "=v"(oz_));
        const int lane = lane_o + oz_, fr = lane & 15, fq = lane >> 4;
        const int t0 = rnd * 128 + 32 * cs;
#pragma unroll
        for (int j = 0; j < 4; ++j) { const int q = lane + 64 * j; const int o = (q >> 3) * 256 + 128 * pp + (q & 7) * 16;
            *(LAS v4u*)(ps + ST_Q + o) = pre[j]; *(LAS v4u*)(ps + ST_K + o) = pre[4 + j]; *(LAS v4u*)(ps + ST_V + o) = pre[8 + j]; }
        LDS_WAIT();
        __syncthreads();
        unsigned qd[16], kx[16], kd[16], vt[16]; float dec;
        { const LAS unsigned short* sq = (const LAS unsigned short*)(ps + ST_Q) + 64 * pp + lane; const LAS unsigned short* sk = (const LAS unsigned short*)(ps + ST_K) + 64 * pp + lane; const LAS unsigned short* sv = (const LAS unsigned short*)(ps + ST_V) + 64 * pp + lane;
          float run = 0.f;
#pragma unroll
          for (int i = 0; i < 32; i += 2) { const float k0 = h1(sk[i * 128]), k1 = h1(sk[(i + 1) * 128]), q0 = bf1(sq[i * 128]), q1 = bf1(sq[(i + 1) * 128]);
              run += __logf(1.f - k0); const float e0 = __expf(run), r0 = __builtin_amdgcn_rcpf(e0); run += __logf(1.f - k1); const float e1 = __expf(run), r1 = __builtin_amdgcn_rcpf(e1);
              qd[i >> 1] = pk2(q0 * e0, q1 * e1); kx[i >> 1] = pk2(k0 * r0, k1 * r1);
              vt[i >> 1] = (unsigned)sv[i * 128] | ((unsigned)sv[(i + 1) * 128] << 16); }
          dec = __expf(run);
#pragma unroll
          for (int i = 0; i < 16; ++i) kd[i] = pk2(bf_lo(kx[i]) * dec, bf_hi(kx[i]) * dec); }
        LDS_WAIT();
        __syncthreads();
        { const int k = 64 * pp + lane; LAS unsigned short* iq = (LAS unsigned short*)(ps + O_QD) + k; LAS unsigned short* ik = (LAS unsigned short*)(ps + O_KX) + k;
#pragma unroll
          for (int i = 0; i < 32; i += 2) { iq[i * 136] = (unsigned short)qd[i >> 1]; iq[(i + 1) * 136] = (unsigned short)(qd[i >> 1] >> 16); ik[i * 136] = (unsigned short)kx[i >> 1]; ik[(i + 1) * 136] = (unsigned short)(kx[i >> 1] >> 16); }
#pragma unroll
          for (int c4 = 0; c4 < 4; ++c4) *(LAS v4u*)(ps + O_KT + (k * 40 + 8 * c4) * 2) = (v4u){kd[4 * c4], kd[4 * c4 + 1], kd[4 * c4 + 2], kd[4 * c4 + 3]};
          ((LAS float*)(ps + O_DEC))[k] = dec; }
        LDS_WAIT();
        __syncthreads();
        {
#pragma unroll
          for (int u = 0; u < 2; ++u) { const int ti = pp ? 1 - u : u, tj = pp ? 1 : 0;
              f4 a = {0.f, 0.f, 0.f, 0.f};
              if (tj <= ti) {
#pragma unroll
                  for (int ks = 0; ks < 4; ++ks) a = MFMA16(*(const LAS bf16x8*)(ps + O_QD + ((16 * ti + fr) * 136 + 32 * ks + 8 * fq) * 2), *(const LAS bf16x8*)(ps + O_KX + ((16 * tj + fr) * 136 + 32 * ks + 8 * fq) * 2), a); }
#pragma unroll
              for (int j = 0; j < 4; ++j) { const int i = 16 * ti + 4 * fq + j, jj = 16 * tj + fr; ((LAS unsigned short*)(ps + O_SC))[i * 40 + jj] = (unsigned short)f2bf(jj <= i ? a[j] : 0.f); } } }
        LDS_WAIT();
        __syncthreads();
        { const int v = 64 * pp + lane;
#pragma unroll
          for (int c4 = 0; c4 < 4; ++c4) *(LAS v4u*)(ps + O_KX + (v * 40 + 8 * c4) * 2) = (v4u){vt[4 * c4], vt[4 * c4 + 1], vt[4 * c4 + 2], vt[4 * c4 + 3]}; }
        LDS_WAIT();
        __syncthreads();
        if (rnd + 1 < SEQ / 128) HG_LOAD(t0 + 128);
        unsigned short hgv[4][2][4];
#pragma unroll
        for (int sl = 0; sl < 4; ++sl)
#pragma unroll
            for (int ti = 0; ti < 2; ++ti)
#pragma unroll
                for (int j = 0; j < 4; ++j) hgv[sl][ti][j] = *(const GAS unsigned short*)(bHG + ((unsigned)(rnd * 128 + 32 * sl + 16 * ti + 4 * fq + j) * 2048u + (16 * wv + fr) * 2u));
        f4 oacc[4][2];
#pragma unroll
        for (int sl = 0; sl < 4; ++sl) { const LAS unsigned char* sb = L + sl * SLOT;
            const bf16x8 vfr = *(const LAS bf16x8*)(sb + O_KX + ((16 * wv + fr) * 40 + 8 * fq) * 2);
            bf16x8 sbf[4];
#pragma unroll
            for (int ks = 0; ks < 4; ++ks) sbf[ks] = op44(St[2 * ks], St[2 * ks + 1]);
#pragma unroll
            for (int ti = 0; ti < 2; ++ti) { f4 o = MFMA16(*(const LAS bf16x8*)(sb + O_SC + ((16 * ti + fr) * 40 + 8 * fq) * 2), vfr, ((f4){0.f, 0.f, 0.f, 0.f}));
#pragma unroll
                for (int ks = 0; ks < 4; ++ks) { const v2u lo = *(const LAS v2u*)(sb + O_QD + ((16 * ti + fr) * 136 + 32 * ks + 4 * fq) * 2), hi = *(const LAS v2u*)(sb + O_QD + ((16 * ti + fr) * 136 + 32 * ks + 16 + 4 * fq) * 2);
                    o = MFMA16(mk8(lo.x, lo.y, hi.x, hi.y), sbf[ks], o); }
                oacc[sl][ti] = o;
#pragma unroll
                for (int j = 0; j < 4; ++j) { const float s_ = red16(o[j] * o[j]); if (fr == 0) ((LAS float*)(sb + O_SSQ))[(16 * ti + 4 * fq + j) * 8 + wv] = s_; } }
#pragma unroll
            for (int t = 0; t < 8; ++t) { const f4 d4 = *(const LAS f4*)(sb + O_DEC + (16 * t + 4 * fq) * 4);
                St[t] = MFMA16(*(const LAS bf16x8*)(sb + O_KT + ((16 * t + fr) * 40 + 8 * fq) * 2), vfr, St[t] * d4); if ((t & 3) == 3) __builtin_amdgcn_sched_barrier(0); } }
        LDS_WAIT();
        __syncthreads();
#pragma unroll
        for (int sl = 0; sl < 4; ++sl) { const LAS unsigned char* sb = L + sl * SLOT;
#pragma unroll
            for (int ti = 0; ti < 2; ++ti)
#pragma unroll
                for (int j = 0; j < 4; ++j) { const int tok = 16 * ti + 4 * fq + j; const LAS f4* sp = (const LAS f4*)(sb + O_SSQ + tok * 32); const f4 s0 = sp[0], s1 = sp[1];
                    const float rstd = __builtin_amdgcn_rsqf(((s0[0] + s0[1]) + (s0[2] + s0[3]) + (s1[0] + s1[1]) + (s1[2] + s1[3])) * (1.f / 128.f) + EPS);
                    const float o = oacc[sl][ti][j] * rstd * g_v * bf1(hgv[sl][ti][j]);
                    if (!dry) *(GAS unsigned short*)(bVI + ((unsigned)(rnd * 128 + 32 * sl + tok) * 2048u + (16 * wv + fr) * 2u)) = (unsigned short)f2bf(o); } }
        LDS_WAIT();
        __syncthreads();
    }
#undef HG_LOAD
}

__device__ __forceinline__ void p5_rows(Frame& F) {
    const int gw = F.bid * NWAVES + F.wave, NGW = F.G * NWAVES, lane = F.lane;
    const float* MIX = (const float*)(F.ws + WS_MIX); const float* SSP = (const float*)(F.ws + WS_SS1); bf16* HB = (bf16*)(F.ws + WS_HB);
    const GAS f32x4* g1 = (const GAS f32x4*)inp(19) + lane; const GAS f32x4* g2 = (const GAS f32x4*)inp(20) + lane;
    for (int m = gw; m < M; m += NGW) {
        const float sp = lane < 16 ? SSP[(size_t)m * 16 + lane] : 0.f;
        const float rstd1 = __builtin_amdgcn_rsqf(wave_sum(sp) * (1.f / D) + EPS);
        const GAS f32x4* mr = (const GAS f32x4*)(MIX + (size_t)m * D) + lane; const GAS f32x4* xr = (const GAS f32x4*)(inp(0) + (size_t)m * D) + lane; GAS f32x4* hr = (GAS f32x4*)(F.out + (size_t)m * D) + lane;
        f32x4 hv[4]; float s = 0.f;
#pragma unroll
        for (int j = 0; j < 4; ++j) { hv[j] = xr[64 * j] + mr[64 * j] * rstd1 * g1[64 * j]; hr[64 * j] = hv[j]; s += (hv[j].x * hv[j].x + hv[j].y * hv[j].y) + (hv[j].z * hv[j].z + hv[j].w * hv[j].w); }
        const float rstd2 = __builtin_amdgcn_rsqf(wave_sum(s) * (1.f / D) + EPS);
        GAS unsigned long long* o8 = (GAS unsigned long long*)(HB + (size_t)m * D) + lane;
#pragma unroll
        for (int j = 0; j < 4; ++j) { const f32x4 gg = g2[64 * j]; o8[64 * j] = (unsigned long long)pk2(hv[j].x * rstd2 * gg.x, hv[j].y * rstd2 * gg.y) | ((unsigned long long)pk2(hv[j].z * rstd2 * gg.z, hv[j].w * rstd2 * gg.w) << 32); }
    }
}
__device__ __forceinline__ void p11_rows(Frame& F) {
    const int gw = F.bid * NWAVES + F.wave, NGW = F.G * NWAVES, lane = F.lane;
    const float* FFo = (const float*)(F.ws + WS_MIX); const float* SSP = (const float*)(F.ws + WS_SS3);
    const GAS f32x4* g3 = (const GAS f32x4*)inp(25) + lane;
    for (int m = gw; m < M; m += NGW) {
        const float sp = lane < 16 ? SSP[(size_t)m * 16 + lane] : 0.f;
        const float rstd = __builtin_amdgcn_rsqf(wave_sum(sp) * (1.f / D) + EPS);
        const GAS f32x4* fr = (const GAS f32x4*)(FFo + (size_t)m * D) + lane; GAS f32x4* hr = (GAS f32x4*)(F.out + (size_t)m * D) + lane;
#pragma unroll
        for (int j = 0; j < 4; ++j) hr[64 * j] = hr[64 * j] + fr[64 * j] * rstd * g3[64 * j];
    }
}
__device__ __forceinline__ void conv_phase(Frame& F, int half) {
    const bf16* HU = (const bf16*)(F.ws + WS_HU); bf16* ACT = (bf16*)(F.ws + WS_ACT);
    const float* cw = inp(22); const float* cb = inp(23);
    constexpr int NCG = DFF / 8, NRR = MH / 32, NT = NCG * NRR;
    for (int task = F.bid * 512 + F.tid; task < NT; task += F.G * 512) {
        const int cgi = task % NCG, rr = task / NCG, c = 8 * cgi, r0 = 32 * rr;
        float wg[3][8], wv[3][8], bg[8], bv[8];
#pragma unroll
        for (int e = 0; e < 8; ++e) { bg[e] = cb[c + e]; bv[e] = cb[DFF + c + e];
#pragma unroll
            for (int j = 0; j < 3; ++j) { wg[j][e] = cw[j * NUP + c + e]; wv[j][e] = cw[j * NUP + DFF + c + e]; } }
        float g1[8], g2[8], v1[8], v2[8];
        const bool seq_start = (r0 % SEQ) == 0;
        auto unpack = [](v4u u, float* o) { o[0] = bf_lo(u.x); o[1] = bf_hi(u.x); o[2] = bf_lo(u.y); o[3] = bf_hi(u.y); o[4] = bf_lo(u.z); o[5] = bf_hi(u.z); o[6] = bf_lo(u.w); o[7] = bf_hi(u.w); };
        if (seq_start) {
#pragma unroll
            for (int e = 0; e < 8; ++e) { g1[e] = g2[e] = v1[e] = v2[e] = 0.f; }
        } else { unpack(*(const GAS v4u*)(HU + (size_t)(r0 - 1) * NUP + c), g1); unpack(*(const GAS v4u*)(HU + (size_t)(r0 - 2) * NUP + c), g2);
                 unpack(*(const GAS v4u*)(HU + (size_t)(r0 - 1) * NUP + DFF + c), v1); unpack(*(const GAS v4u*)(HU + (size_t)(r0 - 2) * NUP + DFF + c), v2); }
#pragma unroll 4
        for (int i = 0; i < 32; ++i) { float g0[8], v0[8]; unpack(*(const GAS v4u*)(HU + (size_t)(r0 + i) * NUP + c), g0); unpack(*(const GAS v4u*)(HU + (size_t)(r0 + i) * NUP + DFF + c), v0);
            float o[8];
#pragma unroll
            for (int e = 0; e < 8; ++e) { const float gt = bg[e] + wg[0][e] * g2[e] + wg[1][e] * g1[e] + wg[2][e] * g0[e]; const float vl = bv[e] + wv[0][e] * v2[e] + wv[1][e] * v1[e] + wv[2][e] * v0[e];
                o[e] = gt * fsig(gt) * vl; g2[e] = g1[e]; g1[e] = g0[e]; v2[e] = v1[e]; v1[e] = v0[e]; }
            v4u w; w.x = pk2(o[0], o[1]); w.y = pk2(o[2], o[3]); w.z = pk2(o[4], o[5]); w.w = pk2(o[6], o[7]);
            *(GAS v4u*)(ACT + (size_t)(half * MH + r0 + i) * DFF + c) = w; }
    }
}

__device__ __forceinline__ bool refresh_tid(Frame& F) {
    int l_; asm volatile("v_mbcnt_lo_u32_b32 %0, -1, 0\n\tv_mbcnt_hi_u32_b32 %0, -1, %0" : "=v"(l_)); F.lane = l_; F.tid = F.wave * 64 + l_; return true;
}
struct Args { const float* in[26]; float* out; unsigned char* ws; int ph_lo, ph_hi; };
__global__ void __launch_bounds__(NWAVES * 64, 2) fwd_kernel(Args args) {
    extern __shared__ __attribute__((aligned(16))) unsigned char lds[];
    Frame F;
    F.lds = (LAS unsigned char*)lds; F.tid = threadIdx.x; F.lane = F.tid & 63; F.wave = __builtin_amdgcn_readfirstlane(F.tid >> 6); F.G = gridDim.x; F.bid = blockIdx.x;
    F.out = args.out; F.ws = args.ws;
    const int lo = args.ph_lo, hi = args.ph_hi;
    if (F.tid < 16) ((LAS unsigned*)(F.lds + MISC_OFF))[F.tid] = 0u;
    __syncthreads();
    XcdBarrier gbar; gbar.bar = (unsigned*)(args.ws + WS_CTL) + CW_BAR; gbar.x = 0; gbar.w = 0; gbar.st = nullptr;
    if (hi - lo > 1) gbar = xcd_barrier_post((unsigned*)(args.ws + WS_CTL) + CW_BAR, (volatile LAS unsigned*)(F.lds + MISC_OFF));
    gbar.w = (unsigned)F.wave;
    if (lo > 1000) cg::this_grid().sync();
#ifndef REP_MASK
#define REP_MASK 0
#endif
#define NREP(k) (1 + ((REP_MASK >> (k)) & 1))
#ifndef DIAG_SCAN
#define DIAG_SCAN 3
#endif
#ifndef DIAG_MASK
#define DIAG_MASK 0x1FFF
#endif
#define IN(k) (((DIAG_MASK >> (k)) & 1) && lo <= (k) && (k) < hi && refresh_tid(F))
#define SEAM(k) do { if (IN(k) && IN((k) + 1)) { xcd_barrier(gbar); } } while (0)
    unsigned char* ws = args.ws; unsigned char* ob = (unsigned char*)args.out;
    if (IN(0)) { _Pragma("unroll 1") for (int rep = 0; rep < NREP(0); ++rep) p0_prologue(F); } SEAM(0);
    if (IN(1)) {
        pg8::Gemm g{(const pg8::bf16_t*)(ob + OUT_XN), (const pg8::bf16_t*)(ws + WS_W1), M, N1, D}; pg8::StaticOrder S; S.init(M, N1, F.G, F.bid);
        pg8::EpiG1 E{(bf16*)(ws + WS_Q), (bf16*)(ws + WS_KF), (bf16*)(ws + WS_VI), (bf16*)(ws + WS_HG), (bf16*)(ws + WS_R), (bf16*)(ws + WS_K), (bf16*)(ob + OUT_V), (bf16*)(ws + WS_LZ), inp(3)};
        _Pragma("unroll 1") for (int rep = 0; rep < NREP(1); ++rep) { pg8::gemm_phase<pg8::EpiG1, pg8::StaticOrder, true, true>(F.lds, g, S, E, F.wave); __syncthreads(); }
    } SEAM(1);
    if (IN(2)) { la_phase(F); } SEAM(2);
    if (IN(3)) {
        if (F.bid < 128) { _Pragma("unroll 1") for (int rep = 0; rep < NREP(3); ++rep) { rwkv_phase(F, F.bid, rep + 1 < NREP(3)); __syncthreads(); } } else if (F.bid < 192) { _Pragma("unroll 1") for (int rep = 0; rep < NREP(13); ++rep) { hgrn_phase(F, F.bid - 128, rep + 1 < NREP(13)); __syncthreads(); } }
    } SEAM(3);
    if (IN(4)) {
        pg8::Gemm g{(const pg8::bf16_t*)(ob + OUT_XN), (const pg8::bf16_t*)(ws + WS_W3), M, 4096, D};
        pg8::OrderG3 S; S.init(M, D, F.G, F.bid); S.a_xn = (const pg8::bf16_t*)(ob + OUT_XN); S.a_oa = (const pg8::bf16_t*)(ws + WS_VI); S.a_ob = (const pg8::bf16_t*)(ob + OUT_V);
        pg8::EpiG3 E{(pg8::f32x4*)(ws + WS_SCR) + (size_t)F.bid * (2 * 32 * 512), F.wave, (bf16*)(ws + WS_MRG)};
        _Pragma("unroll 1") for (int rep = 0; rep < NREP(4); ++rep) { pg8::gemm_phase<pg8::EpiG3, pg8::OrderG3, false, true>(F.lds, g, S, E, F.wave); __syncthreads(); }
    } SEAM(4);
    if (IN(5)) {
        pg8::Gemm g{(const pg8::bf16_t*)(ws + WS_MRG), (const pg8::bf16_t*)(ws + WS_WOUT), M, D, D}; pg8::StaticOrder S; S.init(M, D, F.G, F.bid);
        pg8::EpiF32SS E{(float*)(ws + WS_MIX), (float*)(ws + WS_SS1), D};
        _Pragma("unroll 1") for (int rep = 0; rep < NREP(5); ++rep) { pg8::gemm_phase<pg8::EpiF32SS, pg8::StaticOrder, false, true>(F.lds, g, S, E, F.wave); __syncthreads(); }
    } SEAM(5);
    if (IN(6)) { _Pragma("unroll 1") for (int rep = 0; rep < NREP(6); ++rep) p5_rows(F); } SEAM(6);
#pragma unroll 1
    for (int half = 0; half < 2; ++half) {
        if (IN(7 + 2 * half)) {
            pg8::Gemm g{(const pg8::bf16_t*)(ws + WS_HB) + (size_t)half * MH * D, (const pg8::bf16_t*)(ws + WS_WUP), MH, NUP, D}; pg8::StaticOrder S; S.init(MH, NUP, F.G, F.bid);
            pg8::EpiBf16Raw E{(bf16*)(ws + WS_HU), NUP};
            _Pragma("unroll 1") for (int rep = 0; rep < NREP(7); ++rep) { pg8::gemm_phase<pg8::EpiBf16Raw, pg8::StaticOrder, true, true>(F.lds, g, S, E, F.wave); __syncthreads(); }
        } SEAM(7 + 2 * half);
        if (IN(8 + 2 * half)) { _Pragma("unroll 1") for (int rep = 0; rep < NREP(8); ++rep) conv_phase(F, half); } SEAM(8 + 2 * half);
    }
    if (IN(11)) {
        pg8::Gemm g{(const pg8::bf16_t*)(ws + WS_ACT), (const pg8::bf16_t*)(ws + WS_WDN), M, D, DFF}; pg8::StaticOrder S; S.init(M, D, F.G, F.bid);
        pg8::EpiF32SS E{(float*)(ws + WS_MIX), (float*)(ws + WS_SS3), D};
        _Pragma("unroll 1") for (int rep = 0; rep < NREP(11); ++rep) { pg8::gemm_phase<pg8::EpiF32SS, pg8::StaticOrder, false, true>(F.lds, g, S, E, F.wave); __syncthreads(); }
    } SEAM(11);
    if (IN(12)) { p11_rows(F); }
#undef IN
#undef SEAM
}

extern "C" void kernel_launch(void* const* d_in, const int* in_sizes, int n_in, void* d_out, int out_size, void* d_ws, size_t ws_size, hipStream_t stream) {
    static int grid = 0;
    if (grid == 0) {
        if (n_in != 26 || in_sizes[0] != M * D || out_size != M * D || ws_size < WS_END) { fprintf(stderr, "kernel_launch: unexpected shapes (n_in %d, in0 %d, out %d, ws %zu); nothing launched\n", n_in, n_in > 0 ? in_sizes[0] : -1, out_size, ws_size); grid = -1; return; }
        int dev = 0, cus = 0, per_cu = 0;
        if (hipGetDevice(&dev) != hipSuccess || hipDeviceGetAttribute(&cus, hipDeviceAttributeMultiprocessorCount, dev) != hipSuccess) { grid = -1; return; }
        if (hipFuncSetAttribute((const void*)fwd_kernel, hipFuncAttributeMaxDynamicSharedMemorySize, LDS_BYTES) != hipSuccess) { fprintf(stderr, "kernel_launch: hipFuncSetAttribute failed\n"); grid = -1; return; }
        if (hipOccupancyMaxActiveBlocksPerMultiprocessor(&per_cu, (const void*)fwd_kernel, NWAVES * 64, LDS_BYTES) != hipSuccess || per_cu < 1) { fprintf(stderr, "kernel_launch: occupancy query reports %d blocks per CU\n", per_cu); per_cu = 1; }
        (void)hipGetLastError();
        grid = cus;
    }
    if (grid < 0) return;
    Args a{};
    for (int i = 0; i < 26; ++i) a.in[i] = (const float*)d_in[i];
    a.out = (float*)d_out; a.ws = (unsigned char*)d_ws;
#if MK_ONE_LAUNCH
    a.ph_lo = 0; a.ph_hi = N_PHASES;
    if (hipMemsetAsync((char*)d_ws + WS_CTL, 0, 65536, stream) != hipSuccess) { fprintf(stderr, "kernel_launch: hipMemsetAsync failed\n"); return; }
    void* kargs[] = {&a};
    hipError_t e = hipLaunchCooperativeKernel((const void*)fwd_kernel, dim3(grid), dim3(NWAVES * 64), kargs, LDS_BYTES, stream);
    if (e != hipSuccess) fprintf(stderr, "kernel_launch: cooperative launch failed: %s (grid %d)\n", hipGetErrorString(e), grid);
#else
    for (int ph = 0; ph < N_PHASES; ++ph) {
        a.ph_lo = ph; a.ph_hi = ph + 1;
        hipLaunchKernelGGL(fwd_kernel, dim3(grid), dim3(NWAVES * 64), LDS_BYTES, stream, a);
        const hipError_t le = hipPeekAtLastError();
        if (le != hipSuccess) { fprintf(stderr, "kernel_launch: launch %d failed: %s\n", ph, hipGetErrorName(le)); break; }
    }
#endif
}
```
